# Optimizing an MI355X kernel written in HIP

```python
import math
import jax, jax.numpy as jnp
from jax import lax
import numpy as np

D_MODEL = 2048
BATCH = 2
SEQ = 8192
DEPTH = 1

D_MIX = D_MODEL
ATTN_WIDTH = D_MIX // 2
SSM_WIDTH = D_MIX - ATTN_WIDTH
DIFF_HEAD_DIM = 64
N_DIFF_HEADS = ATTN_WIDTH // (2 * DIFF_HEAD_DIM)
SSM_GROUP = 16
N_SSM_GROUPS = SSM_WIDTH // SSM_GROUP
SSM_STATE = 64
D_FF = ((8 * D_MODEL) // 3 + 255) // 256 * 256
Q_BLOCK = 128
DT_MIN = 1e-3
DT_MAX = 1e-1
LN_EPS = 1e-5
RMS_EPS = 1e-5
DEEPNORM_ALPHA = (2 * DEPTH) ** 0.25
DEEPNORM_BETA = (8 * DEPTH) ** -0.25
FFN_RES_WEIGHT = 0.5
N_SUBLAYERS = 3
IN_COLS = 3 * ATTN_WIDTH + SSM_WIDTH

kernel_name = 'hymba_style_diffattn_s5_macaron_deepnorm_adaln'


def _layer_norm(h, g, b):
    h32 = h.astype(jnp.float32)
    mu = jnp.mean(h32, -1, keepdims=True)
    var = jnp.mean(jnp.square(h32 - mu), -1, keepdims=True)
    out = (h32 - mu) * lax.rsqrt(var + LN_EPS) * g.astype(jnp.float32) + b.astype(jnp.float32)
    return out.astype(h.dtype)


def _modulate(h, shift, scale):
    return h * (1 + scale[:, None, :]) + shift[:, None, :]


def _swiglu(u, w1, w3, w2):
    return (jax.nn.silu(u @ w1) * (u @ w3)) @ w2


def _diff_attention(q, k, v, lq1, lk1, lq2, lk2, subln_g, lambda_init):
    B, L, _ = q.shape
    H, d = N_DIFF_HEADS, DIFF_HEAD_DIM
    q = q.reshape(B, L, H, 2, d)
    k = k.reshape(B, L, H, 2, d)
    v = v.reshape(B, L, H, 2 * d)
    f32 = jnp.float32
    lam = (jnp.exp(jnp.sum(lq1.astype(f32) * lk1.astype(f32)))
           - jnp.exp(jnp.sum(lq2.astype(f32) * lk2.astype(f32))) + lambda_init)
    scale = 1.0 / math.sqrt(d)
    nb = L // Q_BLOCK
    qb = q.reshape(B, nb, Q_BLOCK, H, 2, d).transpose(1, 0, 2, 3, 4, 5)
    k_pos = jnp.arange(L)

    def block(args):
        q_blk, blk = args
        s = jnp.einsum('bqhcd,bkhcd->bhcqk', q_blk, k).astype(f32) * scale
        q_pos = blk * Q_BLOCK + jnp.arange(Q_BLOCK)
        mask = k_pos[None, :] <= q_pos[:, None]
        s = jnp.where(mask, s, -jnp.inf)
        p = jax.nn.softmax(s, axis=-1)
        w = p[:, :, 0] - lam * p[:, :, 1]
        return jnp.einsum('bhqk,bkhe->bqhe', w.astype(v.dtype), v)

    o = lax.map(block, (qb, jnp.arange(nb)))
    o = o.transpose(1, 0, 2, 3, 4).reshape(B, L, H, 2 * d).astype(f32)
    o = o * lax.rsqrt(jnp.mean(jnp.square(o), -1, keepdims=True) + RMS_EPS)
    o = o * subln_g.astype(f32) * (1.0 - lambda_init)
    return o.reshape(B, L, ATTN_WIDTH).astype(q.dtype)


def _s5_branch(s, a_re, a_im, log_dt, b_re, b_im, c_re, c_im, d_skip, glu_w, glu_b):
    B, L, _ = s.shape
    G, P, Hc = N_SSM_GROUPS, SSM_STATE, SSM_GROUP
    f32 = jnp.float32
    a_re = a_re.astype(f32); a_im = a_im.astype(f32)
    b_re = b_re.astype(f32); b_im = b_im.astype(f32)
    dt = jnp.exp(log_dt.astype(f32))[:, None]
    mag = jnp.exp(a_re * dt)
    lbar_re = mag * jnp.cos(a_im * dt)
    lbar_im = mag * jnp.sin(a_im * dt)
    nr = lbar_re - 1.0
    ni = lbar_im
    den = jnp.square(a_re) + jnp.square(a_im)
    coef_re = ((nr * a_re + ni * a_im) / den)[..., None]
    coef_im = ((ni * a_re - nr * a_im) / den)[..., None]
    bb_re = coef_re * b_re - coef_im * b_im
    bb_im = coef_re * b_im + coef_im * b_re
    u = s.astype(f32).reshape(B, L, G, Hc)
    x_re = jnp.einsum('blgh,gph->lbgp', u, bb_re)
    x_im = jnp.einsum('blgh,gph->lbgp', u, bb_im)
    al_re = jnp.broadcast_to(lbar_re[None, None], (L, 1, G, P))
    al_im = jnp.broadcast_to(lbar_im[None, None], (L, 1, G, P))

    def combine(e1, e2):
        a1r, a1i, b1r, b1i = e1
        a2r, a2i, b2r, b2i = e2
        return (a2r * a1r - a2i * a1i,
                a2r * a1i + a2i * a1r,
                a2r * b1r - a2i * b1i + b2r,
                a2r * b1i + a2i * b1r + b2i)

    _, _, h_re, h_im = lax.associative_scan(combine, (al_re, al_im, x_re, x_im), axis=0)
    y = (jnp.einsum('lbgp,ghp->blgh', h_re, c_re.astype(f32))
         - jnp.einsum('lbgp,ghp->blgh', h_im, c_im.astype(f32)))
    y = y.reshape(B, L, SSM_WIDTH) + d_skip.astype(f32) * u.reshape(B, L, SSM_WIDTH)
    g = jax.nn.gelu(y)
    out = g * jax.nn.sigmoid(g @ glu_w.astype(f32) + glu_b.astype(f32))
    return out.astype(s.dtype)


def _hybrid_mixer(u, w_in, lq1, lk1, lq2, lk2, subln_g, a_re, a_im, log_dt, b_re, b_im,
                  c_re, c_im, d_skip, glu_w, glu_b, w_out, lambda_init):
    proj = u @ w_in
    q, k, v, s = jnp.split(proj, [ATTN_WIDTH, 2 * ATTN_WIDTH, 3 * ATTN_WIDTH], axis=-1)
    attn = _diff_attention(q, k, v, lq1, lk1, lq2, lk2, subln_g, lambda_init)
    ssm = _s5_branch(s, a_re, a_im, log_dt, b_re, b_im, c_re, c_im, d_skip, glu_w, glu_b)
    return jnp.concatenate([attn, ssm], axis=-1) @ w_out


def setup_inputs(seed: int = 0) -> dict:
    key = jax.random.key(seed)
    ks = jax.random.split(key, 40)
    f32 = jnp.float32

    def nrm(k, shape, s):
        return jax.random.normal(k, shape, f32) * s

    D, F, G, P, Hc = D_MODEL, D_FF, N_SSM_GROUPS, SSM_STATE, SSM_GROUP
    n_idx = jnp.arange(P, dtype=f32)
    w_in = jnp.concatenate([
        nrm(ks[8], (DEPTH, D, 2 * ATTN_WIDTH), D ** -0.5),
        nrm(ks[9], (DEPTH, D, ATTN_WIDTH), D ** -0.5) * DEEPNORM_BETA,
        nrm(ks[10], (DEPTH, D, SSM_WIDTH), D ** -0.5)], axis=-1)
    return {
        'x': nrm(ks[0], (BATCH, SEQ, D), 1.0),
        'c': nrm(ks[1], (BATCH, D), 1.0),
        'w_cond': nrm(ks[2], (DEPTH, D, N_SUBLAYERS * 3 * D), 0.5 * D ** -0.5),
        'b_cond': nrm(ks[3], (DEPTH, N_SUBLAYERS * 3 * D), 0.01),
        'ffn1_w1': nrm(ks[4], (DEPTH, D, F), D ** -0.5),
        'ffn1_w3': nrm(ks[5], (DEPTH, D, F), D ** -0.5),
        'ffn1_w2': nrm(ks[6], (DEPTH, F, D), F ** -0.5) * DEEPNORM_BETA,
        'w_in': w_in,
        'lambda_q1': nrm(ks[11], (DEPTH, DIFF_HEAD_DIM), 0.1),
        'lambda_k1': nrm(ks[12], (DEPTH, DIFF_HEAD_DIM), 0.1),
        'lambda_q2': nrm(ks[13], (DEPTH, DIFF_HEAD_DIM), 0.1),
        'lambda_k2': nrm(ks[14], (DEPTH, DIFF_HEAD_DIM), 0.1),
        'subln_g': 1.0 + nrm(ks[15], (DEPTH, 2 * DIFF_HEAD_DIM), 0.01),
        'ssm_a_re': -0.5 + nrm(ks[16], (DEPTH, G, P), 0.01),
        'ssm_a_im': math.pi * n_idx + nrm(ks[17], (DEPTH, G, P), 0.01),
        'ssm_log_dt': jax.random.uniform(ks[18], (DEPTH, G), f32, math.log(DT_MIN), math.log(DT_MAX)),
        'ssm_b_re': nrm(ks[19], (DEPTH, G, P, Hc), (2 * Hc) ** -0.5),
        'ssm_b_im': nrm(ks[20], (DEPTH, G, P, Hc), (2 * Hc) ** -0.5),
        'ssm_c_re': nrm(ks[21], (DEPTH, G, Hc, P), (2 * P) ** -0.5),
        'ssm_c_im': nrm(ks[22], (DEPTH, G, Hc, P), (2 * P) ** -0.5),
        'ssm_d': nrm(ks[23], (DEPTH, SSM_WIDTH), 1.0),
        'glu_w': nrm(ks[24], (DEPTH, SSM_WIDTH, SSM_WIDTH), SSM_WIDTH ** -0.5),
        'glu_b': nrm(ks[25], (DEPTH, SSM_WIDTH), 0.01),
        'w_out': nrm(ks[26], (DEPTH, D_MIX, D), D_MIX ** -0.5) * DEEPNORM_BETA,
        'ffn2_w1': nrm(ks[27], (DEPTH, D, F), D ** -0.5),
        'ffn2_w3': nrm(ks[28], (DEPTH, D, F), D ** -0.5),
        'ffn2_w2': nrm(ks[29], (DEPTH, F, D), F ** -0.5) * DEEPNORM_BETA,
        'ln_g': 1.0 + nrm(ks[30], (DEPTH, N_SUBLAYERS, D), 0.01),
        'ln_b': nrm(ks[31], (DEPTH, N_SUBLAYERS, D), 0.01),
    }


def reference(x, c, w_cond, b_cond, ffn1_w1, ffn1_w3, ffn1_w2, w_in, lambda_q1, lambda_k1,
              lambda_q2, lambda_k2, subln_g, ssm_a_re, ssm_a_im, ssm_log_dt, ssm_b_re, ssm_b_im,
              ssm_c_re, ssm_c_im, ssm_d, glu_w, glu_b, w_out, ffn2_w1, ffn2_w3, ffn2_w2, ln_g, ln_b):
    B = x.shape[0]
    for i in range(DEPTH):
        lambda_init = 0.8 - 0.6 * math.exp(-0.3 * i)
        mod = (jax.nn.silu(c) @ w_cond[i] + b_cond[i]).reshape(B, N_SUBLAYERS, 3, D_MODEL).astype(x.dtype)

        u = _modulate(x, mod[:, 0, 0], mod[:, 0, 1])
        h = _swiglu(u, ffn1_w1[i], ffn1_w3[i], ffn1_w2[i])
        x = _layer_norm(DEEPNORM_ALPHA * x + FFN_RES_WEIGHT * (1 + mod[:, 0, 2])[:, None, :] * h,
                        ln_g[i, 0], ln_b[i, 0])

        u = _modulate(x, mod[:, 1, 0], mod[:, 1, 1])
        h = _hybrid_mixer(u, w_in[i], lambda_q1[i], lambda_k1[i], lambda_q2[i], lambda_k2[i], subln_g[i],
                          ssm_a_re[i], ssm_a_im[i], ssm_log_dt[i], ssm_b_re[i], ssm_b_im[i],
                          ssm_c_re[i], ssm_c_im[i], ssm_d[i], glu_w[i], glu_b[i], w_out[i], lambda_init)
        x = _layer_norm(DEEPNORM_ALPHA * x + (1 + mod[:, 1, 2])[:, None, :] * h, ln_g[i, 1], ln_b[i, 1])

        u = _modulate(x, mod[:, 2, 0], mod[:, 2, 1])
        h = _swiglu(u, ffn2_w1[i], ffn2_w3[i], ffn2_w2[i])
        x = _layer_norm(DEEPNORM_ALPHA * x + FFN_RES_WEIGHT * (1 + mod[:, 2, 2])[:, None, :] * h,
                        ln_g[i, 2], ln_b[i, 2])
    return x
```

```cpp
#define MK_N_LAUNCHES 1
#define MK_ATTN_P2 1
#define MK_YBF16 1
#define MK_DUP 0
#include <hip/hip_runtime.h>
#include <cstdio>
#include <cstdint>
namespace pg8 {
#define PG8_LAS __attribute__((address_space(3)))
typedef unsigned short bf16_t;
typedef short bf16x8 __attribute__((ext_vector_type(8)));
typedef float f32x4 __attribute__((ext_vector_type(4)));
typedef unsigned u32x4 __attribute__((ext_vector_type(4)));
constexpr int BM = 256, BK = 64, HALF = 128, HTB = HALF * BK * 2  , STAGE_BYTES = 8 * HTB, NXCD = 8, WGM = 8;

__host__ __device__ __forceinline__ int lds_byte(int r, int c) { const int st = (r >> 4) * 2 + (c >> 5), rr = r & 15, cc = c & 31, ob = rr * 64 + cc * 2; return st * 1024 + (ob ^ (((ob >> 9) & 1) << 5)); }
__host__ __device__ __forceinline__ void stage_rc(int b, int& R, int& C) { const int st = b / 1024, sb = b % 1024, swz = sb ^ (((sb >> 9) & 1) << 5); R = (st >> 1) * 16 + swz / 64; C = (st & 1) * 32 + (swz % 64) / 2; }
__host__ __device__ __forceinline__ int perm32(int rho) { const int n = rho >> 4, i = rho & 15; return 8 * (i >> 2) + 4 * n + (i & 3); }

struct Unit { int pm, pn; };
struct Gemm { const bf16_t* A; const bf16_t* Bt; int M, N, K; };

struct StaticOrder {
    int nM, nN, nwg, G, c;
    __host__ __device__ void init(int M, int N, int G_, int c_) { nM = M / BM; nN = N / BM; nwg = nM * nN; G = G_; c = c_; }
    __host__ __device__ bool next(int i, Unit& u) const {
        const long L = (long)i * G + c; if (L >= nwg) return false;
        int wgid = (int)L; { const int q = nwg / NXCD, r = nwg % NXCD, xcd = wgid % NXCD, off = wgid / NXCD; wgid = (xcd < r ? xcd * (q + 1) : r * (q + 1) + (xcd - r) * q) + off; }
        const int nig = WGM * nN, gid = wgid / nig, fm = gid * WGM, gsz = (nM - fm) < WGM ? (nM - fm) : WGM;
        u.pm = fm + ((wgid % nig) % gsz); u.pn = (wgid % nig) / gsz; return true;
    }
    __device__ __forceinline__ void a_ready(const Unit&) const {}
    __device__ __forceinline__ void done(const Unit&) const {}
};

__device__ __forceinline__ unsigned cvt_pk_bf16(float lo, float hi) { unsigned r; asm volatile("v_cvt_pk_bf16_f32 %0, %1, %2" : "=v"(r) : "v"(lo), "v"(hi)); return r; }
typedef float f32x2 __attribute__((ext_vector_type(2)));
__device__ __forceinline__ f32x2 gelu_pk(f32x2 v) {
    const f32x2 av = __builtin_elementwise_abs(v), d = av * 0.2316418882f + 1.0f;
    f32x2 t; t.x = __builtin_amdgcn_rcpf(d.x); t.y = __builtin_amdgcn_rcpf(d.y);
    f32x2 q = t * 0.5307027145f + (-0.7265760135f); q = q * t + 0.7107068705f; q = q * t + (-0.142248368f); q = q * t + 0.127414796f; q = q * t;
    const f32x2 s = (v * v) * (-0.72134752044f);
    f32x2 e; e.x = __builtin_amdgcn_exp2f(s.x); e.y = __builtin_amdgcn_exp2f(s.y);
    const f32x2 m = v * (q * e), r = v - m;
    f32x2 o; o.x = v.x < 0.f ? m.x : r.x; o.y = v.y < 0.f ? m.y : r.y; return o;
}

__device__ __forceinline__ float silu_f(float a) { return a * __builtin_amdgcn_rcpf(1.f + __builtin_amdgcn_exp2f(-1.44269504089f * a)); }
__device__ __forceinline__ float sigm_f(float a) { return __builtin_amdgcn_rcpf(1.f + __builtin_amdgcn_exp2f(-1.44269504089f * a)); }
struct EpiSwiGLU {
    static constexpr bool PERM = true, AFTER_DRAIN = false;
    bf16_t* O; int ldc;
    __device__ __forceinline__ void operator()(const f32x4 (&acc)[2][2][4][2], const Unit& u, int wr, int wc, int fr, int fq) const {
        const int row0 = u.pm * BM + wr * 64 + fr, col0 = u.pn * HALF + wc * 32 + 8 * fq;
#pragma unroll
        for (int ai = 0; ai < 2; ++ai)
#pragma unroll
            for (int m = 0; m < 4; ++m) { bf16_t* rowp = O + (size_t)(row0 + ai * HALF + m * 16) * ldc + col0;
                const f32x4 a0 = acc[ai][0][m][0], a1 = acc[ai][0][m][1], b0 = acc[ai][1][m][0], b1 = acc[ai][1][m][1];
                f32x4 v0, v1;
#pragma unroll
                for (int i = 0; i < 4; ++i) { v0[i] = silu_f(a0[i]) * b0[i]; v1[i] = silu_f(a1[i]) * b1[i]; }
                u32x4 w; w.x = cvt_pk_bf16(v0[0], v0[1]); w.y = cvt_pk_bf16(v0[2], v0[3]); w.z = cvt_pk_bf16(v1[0], v1[1]); w.w = cvt_pk_bf16(v1[2], v1[3]);
                *(u32x4*)rowp = w; }
    }
};
template <bool LNRES, bool YBF> struct EpiResid2 {
    static constexpr bool PERM = true, AFTER_DRAIN = false;
    const void* res; void* out; const float* stats; const float* lng; const float* lnb; const float* gate; int gate_bstride; float alpha, coef;
    __device__ __forceinline__ void operator()(const f32x4 (&acc)[2][2][4][2], const Unit& u, int wr, int wc, int fr, int fq) const {
        const int b = u.pm >> 5;
        const int col0 = u.pn * BM + wc * 32 + 8 * fq;
        f32x4 gv[2][2], ag[2][2], ab[2][2];
#pragma unroll
        for (int bj = 0; bj < 2; ++bj)
#pragma unroll
            for (int n = 0; n < 2; ++n) { const int c = col0 + bj * HALF + 4 * n;
                gv[bj][n] = (*(const f32x4*)(gate + (size_t)b * gate_bstride + c) + 1.0f) * coef;
                if (LNRES) { ag[bj][n] = *(const f32x4*)(lng + c) * alpha; ab[bj][n] = *(const f32x4*)(lnb + c) * alpha; } }
#pragma unroll
        for (int ai = 0; ai < 2; ++ai)
#pragma unroll
            for (int m = 0; m < 4; ++m) { const int row = u.pm * BM + ai * HALF + wr * 64 + m * 16 + fr;
                float mean = 0.f, rstd = 1.f;
                if (LNRES) { const f32x2 st = *(const f32x2*)(stats + 2 * (size_t)row); mean = st.x; rstd = st.y; }
#pragma unroll
                for (int bj = 0; bj < 2; ++bj) { const size_t off = (size_t)row * 2048 + col0 + bj * HALF;
                    f32x4 x0, x1;
                    if (LNRES && YBF) { const u32x4 w = *(const u32x4*)((const bf16_t*)res + off);
                        x0 = (f32x4){__uint_as_float(w.x << 16), __uint_as_float(w.x & 0xffff0000u), __uint_as_float(w.y << 16), __uint_as_float(w.y & 0xffff0000u)};
                        x1 = (f32x4){__uint_as_float(w.z << 16), __uint_as_float(w.z & 0xffff0000u), __uint_as_float(w.w << 16), __uint_as_float(w.w & 0xffff0000u)}; }
                    else { x0 = *(const f32x4*)((const float*)res + off); x1 = *(const f32x4*)((const float*)res + off + 4); }
                    f32x4 o0, o1;
                    if (LNRES) { o0 = (x0 - mean) * rstd * ag[bj][0] + ab[bj][0] + gv[bj][0] * acc[ai][bj][m][0]; o1 = (x1 - mean) * rstd * ag[bj][1] + ab[bj][1] + gv[bj][1] * acc[ai][bj][m][1]; }
                    else { o0 = x0 * alpha + gv[bj][0] * acc[ai][bj][m][0]; o1 = x1 * alpha + gv[bj][1] * acc[ai][bj][m][1]; }
                    if (YBF) { u32x4 w; w.x = cvt_pk_bf16(o0[0], o0[1]); w.y = cvt_pk_bf16(o0[2], o0[3]); w.z = cvt_pk_bf16(o1[0], o1[1]); w.w = cvt_pk_bf16(o1[2], o1[3]); *(u32x4*)((bf16_t*)out + off) = w; }
                    else { *(f32x4*)((float*)out + off) = o0; *(f32x4*)((float*)out + off + 4) = o1; } }
                asm volatile("" ::: "memory"); }
    }
};
struct EpiInProj {
    static constexpr bool PERM = true, AFTER_DRAIN = false;
    bf16_t* Q; bf16_t* K; bf16_t* V; float* S; float qscale;
    __device__ __forceinline__ void operator()(const f32x4 (&acc)[2][2][4][2], const Unit& u, int wr, int wc, int fr, int fq) const {
        const int t = u.pn >> 2, row0 = u.pm * BM + wr * 64 + fr, col0 = (u.pn & 3) * BM + wc * 32 + 8 * fq;
        if (t == 3) {
#pragma unroll
            for (int ai = 0; ai < 2; ++ai)
#pragma unroll
                for (int m = 0; m < 4; ++m) { float* rowp = S + (size_t)(row0 + ai * HALF + m * 16) * 1024 + col0;
#pragma unroll
                    for (int bj = 0; bj < 2; ++bj) { *(f32x4*)(rowp + bj * HALF) = acc[ai][bj][m][0]; *(f32x4*)(rowp + bj * HALF + 4) = acc[ai][bj][m][1]; } }
        } else {
            bf16_t* base = Q + (size_t)t * (size_t)(K - Q); const float sc = t == 0 ? qscale : 1.0f;
#pragma unroll
            for (int ai = 0; ai < 2; ++ai)
#pragma unroll
                for (int m = 0; m < 4; ++m) { bf16_t* rowp = base + (size_t)(row0 + ai * HALF + m * 16) * 1024 + col0;
#pragma unroll
                    for (int bj = 0; bj < 2; ++bj) { const f32x4 v0 = acc[ai][bj][m][0] * sc, v1 = acc[ai][bj][m][1] * sc;
                        u32x4 w; w.x = cvt_pk_bf16(v0[0], v0[1]); w.y = cvt_pk_bf16(v0[2], v0[3]); w.z = cvt_pk_bf16(v1[0], v1[1]); w.w = cvt_pk_bf16(v1[2], v1[3]);
                        *(u32x4*)(rowp + bj * HALF) = w; } }
        }
    }
};
struct EpiGLU {
    static constexpr bool PERM = true, AFTER_DRAIN = false;
    const bf16_t* G; int ldg; bf16_t* O; int ldo; const float* bias;
    __device__ __forceinline__ void operator()(const f32x4 (&acc)[2][2][4][2], const Unit& u, int wr, int wc, int fr, int fq) const {
        const int row0 = u.pm * BM + wr * 64 + fr, col0 = u.pn * BM + wc * 32 + 8 * fq;
        f32x4 bv[2][2];
#pragma unroll
        for (int bj = 0; bj < 2; ++bj)
#pragma unroll
            for (int n = 0; n < 2; ++n) bv[bj][n] = *(const f32x4*)(bias + col0 + bj * HALF + 4 * n);
#pragma unroll
        for (int ai = 0; ai < 2; ++ai)
#pragma unroll
            for (int m = 0; m < 4; ++m) { const int row = row0 + ai * HALF + m * 16;
#pragma unroll
                for (int bj = 0; bj < 2; ++bj) { const u32x4 gw = *(const u32x4*)(G + (size_t)row * ldg + col0 + bj * HALF);
                    const f32x4 z0 = acc[ai][bj][m][0] + bv[bj][0], z1 = acc[ai][bj][m][1] + bv[bj][1];
                    float g[8]; g[0] = __uint_as_float(gw.x << 16); g[1] = __uint_as_float(gw.x & 0xffff0000u); g[2] = __uint_as_float(gw.y << 16); g[3] = __uint_as_float(gw.y & 0xffff0000u);
                    g[4] = __uint_as_float(gw.z << 16); g[5] = __uint_as_float(gw.z & 0xffff0000u); g[6] = __uint_as_float(gw.w << 16); g[7] = __uint_as_float(gw.w & 0xffff0000u);
                    float o[8];
#pragma unroll
                    for (int i = 0; i < 4; ++i) { o[i] = g[i] * sigm_f(z0[i]); o[4 + i] = g[4 + i] * sigm_f(z1[i]); }
                    u32x4 w; w.x = cvt_pk_bf16(o[0], o[1]); w.y = cvt_pk_bf16(o[2], o[3]); w.z = cvt_pk_bf16(o[4], o[5]); w.w = cvt_pk_bf16(o[6], o[7]);
                    *(u32x4*)(O + (size_t)row * ldo + col0 + bj * HALF) = w; } }
    }
};

template <class Epi, class Sched, bool ALIGN_EPI = false, bool SP2 = false>
__device__ __forceinline__ void gemm_phase(PG8_LAS unsigned char* lds, const Gemm g, const Sched& S, const Epi& E) {
    const int tid = threadIdx.x, wid = __builtin_amdgcn_readfirstlane(tid >> 6), lane = tid & 63, wr = wid >> 2, wc = wid & 3, fr = lane & 15, fq = lane >> 4;
    const int K = g.K, nt = K / BK;
    unsigned voffA[2], voffB[2];
#pragma unroll
    for (int i = 0; i < 2; ++i) { int R, C; stage_rc(tid * 16 + i * 8192, R, C); const int Rb = Epi::PERM ? ((R & ~31) + perm32(R & 31)) : R;
        voffA[i] = (unsigned)(R * K + C) * 2u; voffB[i] = (unsigned)(Rb * K + C) * 2u; }
    const size_t kstep = (size_t)(BK * 2);
    const size_t hstep = (size_t)HALF * K * 2;
    const size_t tstep = 2 * hstep;
    const unsigned ldsw = (unsigned)wid * 1024u;
    const int aoff = lds_byte(wr * 64 + fr, fq * 8), boff = lds_byte(wc * 32 + fr, fq * 8);
#define PG8_SA(b, h) (((b) * 2 + (h)) * HTB)
#define PG8_SB(b, h) ((4 + (b) * 2 + (h)) * HTB)
#define PG8_STAGE(bufoff, gbase, voff) do { _Pragma("unroll") for (int _i = 0; _i < 2; ++_i) \
        __builtin_amdgcn_global_load_lds((const unsigned*)((const char*)(gbase) + (voff)[_i]), (PG8_LAS unsigned*)(lds + (bufoff) + ldsw + _i * 8192), 16, 0, 0); } while (0)
#define PG8_LDA(dst, b, h) do { _Pragma("unroll") for (int m = 0; m < 4; ++m) _Pragma("unroll") for (int k = 0; k < 2; ++k) dst[m][k] = *(const PG8_LAS bf16x8*)(lds + PG8_SA(b, h) + aoff + m * 2048 + k * 1024); } while (0)
#define PG8_LDB(dst, b, h) do { _Pragma("unroll") for (int n = 0; n < 2; ++n) _Pragma("unroll") for (int k = 0; k < 2; ++k) dst[n][k] = *(const PG8_LAS bf16x8*)(lds + PG8_SB(b, h) + boff + n * 2048 + k * 1024); } while (0)
#define PG8_MMA(ai, bj, At, Bt) do { __builtin_amdgcn_s_setprio(1); _Pragma("unroll") for (int m = 0; m < 4; ++m) _Pragma("unroll") for (int n = 0; n < 2; ++n) _Pragma("unroll") for (int k = 0; k < 2; ++k) \
        acc[ai][bj][m][n] = __builtin_amdgcn_mfma_f32_16x16x32_bf16(Bt[n][k], At[m][k], acc[ai][bj][m][n], 0, 0, 0); __builtin_amdgcn_s_setprio(0); } while (0)
#define PG8_WAIT_V(n) asm volatile("s_waitcnt vmcnt(" #n ")" ::: "memory")
#define PG8_WAIT_L(n) asm volatile("s_waitcnt lgkmcnt(" #n ")" ::: "memory")
#define PG8_BAR __builtin_amdgcn_s_barrier()
#define PG8_SCHED __builtin_amdgcn_sched_barrier(0)
    Unit cur, nxt; int ui = 0;
    if (!S.next(0, cur)) return;
    f32x4 acc[2][2][4][2];
#pragma unroll
    for (int a = 0; a < 2; ++a)
#pragma unroll
        for (int b = 0; b < 2; ++b)
#pragma unroll
            for (int m = 0; m < 4; ++m)
#pragma unroll
                for (int n = 0; n < 2; ++n) acc[a][b][m][n] = (f32x4){0.f, 0.f, 0.f, 0.f};
    bf16x8 At[4][2], B0[2][2], B1[2][2];
    const char* cA = (const char*)g.A + (size_t)cur.pm * tstep; const char* cB = (const char*)g.Bt + (size_t)cur.pn * tstep;
    S.a_ready(cur);
    if constexpr (SP2) {
        PG8_STAGE(PG8_SB(0, 0), cB, voffB); PG8_STAGE(PG8_SB(0, 1), cB + hstep, voffB); PG8_STAGE(PG8_SA(0, 0), cA, voffA); PG8_STAGE(PG8_SA(0, 1), cA + hstep, voffA);
        if (wr == 1) PG8_BAR;
        PG8_WAIT_V(2); PG8_BAR;
        PG8_STAGE(PG8_SB(1, 0), cB + kstep, voffB); PG8_STAGE(PG8_SA(1, 0), cA + kstep, voffA); PG8_STAGE(PG8_SB(1, 1), cB + hstep + kstep, voffB);
        PG8_WAIT_V(6); PG8_BAR;
    } else {
        PG8_STAGE(PG8_SB(0, 0), cB, voffB); PG8_STAGE(PG8_SA(0, 0), cA, voffA); PG8_STAGE(PG8_SB(0, 1), cB + hstep, voffB); PG8_STAGE(PG8_SA(0, 1), cA + hstep, voffA);
        if (wr == 1) PG8_BAR;
        PG8_WAIT_V(4); PG8_BAR;
        PG8_STAGE(PG8_SB(1, 0), cB + kstep, voffB); PG8_STAGE(PG8_SA(1, 0), cA + kstep, voffA); PG8_STAGE(PG8_SB(1, 1), cB + hstep + kstep, voffB);
        PG8_WAIT_V(6); PG8_BAR;
    }
    for (;;) {
        const bool has_next = S.next(ui + 1, nxt);
        const char* nA = has_next ? (const char*)g.A + (size_t)nxt.pm * tstep : cA; const char* nB = has_next ? (const char*)g.Bt + (size_t)nxt.pn * tstep : cB;
        for (int t = 0; t < nt; t += 2) {
            const bool last = (t == nt - 2);
            const char* a1 = cA + (size_t)(t + 1) * kstep;
            const char* a2 = last ? nA : cA + (size_t)(t + 2) * kstep; const char* b2 = last ? nB : cB + (size_t)(t + 2) * kstep;
            const char* a3 = a2 + kstep; const char* b3 = b2 + kstep;
            if (last && has_next) S.a_ready(nxt);
            if constexpr (SP2) {
            PG8_LDB(B0, 0, 0); PG8_LDB(B1, 0, 1); PG8_SCHED; PG8_LDA(At, 0, 0); PG8_STAGE(PG8_SA(1, 1), a1 + hstep, voffA);
            PG8_WAIT_V(8); PG8_WAIT_L(0); PG8_BAR; PG8_MMA(0, 0, At, B0); PG8_MMA(0, 1, At, B1); PG8_BAR; PG8_SCHED;
            PG8_LDA(At, 0, 1); PG8_STAGE(PG8_SB(0, 0), b2, voffB); PG8_STAGE(PG8_SB(0, 1), b2 + hstep, voffB); PG8_STAGE(PG8_SA(0, 0), a2, voffA);
            PG8_WAIT_V(8); PG8_WAIT_L(0); PG8_BAR; PG8_MMA(1, 0, At, B0); PG8_MMA(1, 1, At, B1); PG8_BAR; PG8_SCHED;
            PG8_LDB(B0, 1, 0); PG8_LDB(B1, 1, 1); PG8_SCHED; PG8_LDA(At, 1, 0); PG8_STAGE(PG8_SA(0, 1), a2 + hstep, voffA);
            PG8_WAIT_V(8); PG8_WAIT_L(0); PG8_BAR; PG8_MMA(0, 0, At, B0); PG8_MMA(0, 1, At, B1); PG8_BAR; PG8_SCHED;
            PG8_LDA(At, 1, 1); PG8_STAGE(PG8_SB(1, 0), b3, voffB); PG8_STAGE(PG8_SB(1, 1), b3 + hstep, voffB); PG8_STAGE(PG8_SA(1, 0), a3, voffA);
            PG8_WAIT_V(8); PG8_WAIT_L(0); PG8_BAR; PG8_MMA(1, 0, At, B0); PG8_MMA(1, 1, At, B1); PG8_BAR; PG8_SCHED;
            } else {
            PG8_LDB(B0, 0, 0); PG8_SCHED; PG8_LDA(At, 0, 0); PG8_STAGE(PG8_SA(1, 1), a1 + hstep, voffA);
            PG8_WAIT_L(8); PG8_BAR; PG8_WAIT_L(0); PG8_MMA(0, 0, At, B0); PG8_BAR; PG8_SCHED;
            PG8_LDB(B1, 0, 1); PG8_STAGE(PG8_SB(0, 0), b2, voffB);
            PG8_BAR; PG8_WAIT_L(0); PG8_MMA(0, 1, At, B1); PG8_BAR;
            PG8_LDA(At, 0, 1); PG8_STAGE(PG8_SA(0, 0), a2, voffA);
            PG8_BAR; PG8_WAIT_L(0); PG8_MMA(1, 0, At, B0); PG8_BAR; PG8_SCHED;
            PG8_STAGE(PG8_SB(0, 1), b2 + hstep, voffB);
            PG8_WAIT_V(6); PG8_BAR; PG8_MMA(1, 1, At, B1); PG8_BAR;
            PG8_LDB(B0, 1, 0); PG8_SCHED; PG8_LDA(At, 1, 0); PG8_STAGE(PG8_SA(0, 1), a2 + hstep, voffA);
            PG8_WAIT_L(8); PG8_BAR; PG8_WAIT_L(0); PG8_MMA(0, 0, At, B0); PG8_BAR; PG8_SCHED;
            PG8_LDB(B1, 1, 1); PG8_STAGE(PG8_SB(1, 0), b3, voffB);
            PG8_BAR; PG8_WAIT_L(0); PG8_MMA(0, 1, At, B1); PG8_BAR;
            PG8_LDA(At, 1, 1); PG8_STAGE(PG8_SA(1, 0), a3, voffA);
            PG8_BAR; PG8_WAIT_L(0); PG8_MMA(1, 0, At, B0); PG8_BAR; PG8_SCHED;
            PG8_STAGE(PG8_SB(1, 1), b3 + hstep, voffB);
            PG8_WAIT_V(6); PG8_BAR; PG8_MMA(1, 1, At, B1); PG8_BAR;
            }
        }
        if constexpr (ALIGN_EPI) { if (wr == 0) PG8_BAR; }
        if constexpr (!Epi::AFTER_DRAIN) { E(acc, cur, wr, wc, fr, fq); S.done(cur); }
        if (!has_next) break;
#pragma unroll
        for (int a = 0; a < 2; ++a)
#pragma unroll
            for (int b = 0; b < 2; ++b)
#pragma unroll
                for (int m = 0; m < 4; ++m)
#pragma unroll
                    for (int n = 0; n < 2; ++n) acc[a][b][m][n] = (f32x4){0.f, 0.f, 0.f, 0.f};
        cur = nxt; cA = nA; cB = nB; ++ui;
        if constexpr (ALIGN_EPI) { if (wr == 1) PG8_BAR; }
    }
    PG8_WAIT_V(0);
    if constexpr (!ALIGN_EPI) { if (wr == 0) PG8_BAR; }
    PG8_BAR;
    if constexpr (Epi::AFTER_DRAIN) { E.fused(acc, cur, wr, wc, fr, fq, lds, wid, lane); S.done(cur); }
#undef PG8_SA
#undef PG8_SB
#undef PG8_STAGE
#undef PG8_LDA
#undef PG8_LDB
#undef PG8_MMA
#undef PG8_WAIT_V
#undef PG8_WAIT_L
#undef PG8_BAR
#undef PG8_SCHED
}
}

#ifndef PG8_SP2
#define PG8_SP2 true
#endif
#ifndef PG8_ALIGN
#define PG8_ALIGN true
#endif
#include <hip/hip_bf16.h>
#include <cmath>
namespace attn_body {
using bf16=__hip_bfloat16;
using bf16x8=__attribute__((ext_vector_type(8)))short;
using s16x4=__attribute__((ext_vector_type(4)))short;
using f32x16=__attribute__((ext_vector_type(16)))float;
using u32x4=__attribute__((ext_vector_type(4)))unsigned;
constexpr int BATCH=2,NVH=32,SEQ=8192,D=64,PQ=1024,PO=2048;
constexpr int NW=8,QBLK=32,QB=QBLK*NW,KVBLK=64,NQB=SEQ/QB;
constexpr int ATTN_UNIT_ROWS=QB;
__device__ __forceinline__ int crow(int r,int hi){return (r&3)+8*(r>>2)+4*hi;}
#define SBAR() __builtin_amdgcn_sched_barrier(0)
__device__ __forceinline__ void cmask(f32x16&p0,f32x16&p1,int jb,int qrel,int hi){
  const float NEG=-INFINITY; int kb=64*jb+4*hi;
  #pragma unroll
  for(int r=0;r<16;++r){int kv=kb+(r&3)+8*(r>>2); if(kv>qrel)p0[r]=NEG; if(kv+32>qrel)p1[r]=NEG;}
}

constexpr int NSLOT=3, SLOTB=8192;
constexpr int LDS_K=0, LDS_V=NSLOT*SLOTB, LDS_WS=2*NSLOT*SLOTB, LDS_OST=LDS_WS+NW*64*4, LDS_BYTES=LDS_OST+NW*4096;
constexpr float C2=0.125f*1.4426950408889634f;
__device__ __forceinline__ void glds16(const void*gsrc,unsigned lds_dst){unsigned keep;
  asm volatile("s_mov_b32 %0, m0\n\ts_mov_b32 m0, %2\n\ts_nop 0\n\tglobal_load_lds_dwordx4 %1, off\n\ts_mov_b32 m0, %0":"=&s"(keep):"v"(gsrc),"s"(lds_dst):"memory");}
__device__ __forceinline__ float max3f(float a,float b,float c){float r;asm("v_max3_f32 %0, %1, %2, %3":"=v"(r):"v"(a),"v"(b),"v"(c));return r;}
__device__ __forceinline__ float max2f(float a,float b){float r;asm("v_max_f32_e32 %0, %1, %2":"=v"(r):"v"(a),"v"(b));return r;}
__device__ __forceinline__ float fadd_s(float a,float b){float r;asm("v_add_f32_e32 %0, %1, %2":"=v"(r):"v"(a),"v"(b));return r;}
__device__ __forceinline__ float fsub_s(float a,float b){float r;asm("v_sub_f32_e32 %0, %1, %2":"=v"(r):"v"(a),"v"(b));return r;}
typedef float f32x2_t __attribute__((ext_vector_type(2))); typedef __bf16 bf16x2_t __attribute__((ext_vector_type(2)));
__device__ __forceinline__ unsigned cvtpk_s(float lo,float hi){f32x2_t v={lo,hi};bf16x2_t b=__builtin_convertvector(v,bf16x2_t);return __builtin_bit_cast(unsigned,b);}
#define WAIT_BAR(N) asm volatile("s_waitcnt vmcnt(" #N ") lgkmcnt(0)\n\ts_barrier":::"memory")

__device__ __forceinline__ void qkt(f32x16&p0,f32x16&p1,const char*Kslot,const bf16x8*qr,const f32x16&negm,int r32,int hi){
  const char*kb=Kslot+hi*1024+r32*16;
  #pragma unroll
  for(int d0=0;d0<4;++d0){
    const bf16x8 b0=*reinterpret_cast<const bf16x8*>(kb+d0*2048);
    const bf16x8 b1=*reinterpret_cast<const bf16x8*>(kb+d0*2048+512);
    if(d0==0){p0=__builtin_amdgcn_mfma_f32_32x32x16_bf16(b0,qr[0],negm,0,0,0);p1=__builtin_amdgcn_mfma_f32_32x32x16_bf16(b1,qr[0],negm,0,0,0);}
    else{p0=__builtin_amdgcn_mfma_f32_32x32x16_bf16(b0,qr[d0],p0,0,0,0);p1=__builtin_amdgcn_mfma_f32_32x32x16_bf16(b1,qr[d0],p1,0,0,0);}}
}
typedef __attribute__((address_space(3))) const char* lds_cptr;
typedef short v4i16_t __attribute__((ext_vector_type(4)));
__device__ __forceinline__ void kload8(bf16x8*kf,lds_cptr kp){
  kf[0]=*(const __attribute__((address_space(3))) bf16x8*)(kp);      kf[1]=*(const __attribute__((address_space(3))) bf16x8*)(kp+512);
  kf[2]=*(const __attribute__((address_space(3))) bf16x8*)(kp+2048); kf[3]=*(const __attribute__((address_space(3))) bf16x8*)(kp+2560);
  kf[4]=*(const __attribute__((address_space(3))) bf16x8*)(kp+4096); kf[5]=*(const __attribute__((address_space(3))) bf16x8*)(kp+4608);
  kf[6]=*(const __attribute__((address_space(3))) bf16x8*)(kp+6144); kf[7]=*(const __attribute__((address_space(3))) bf16x8*)(kp+6656);
}
__device__ __forceinline__ void kload2(bf16x8*kf,lds_cptr kp,int j){ kf[2*j]=*(const __attribute__((address_space(3))) bf16x8*)(kp+j*2048); kf[2*j+1]=*(const __attribute__((address_space(3))) bf16x8*)(kp+j*2048+512); }
__device__ __forceinline__ s16x4 vtr(lds_cptr p){ return __builtin_bit_cast(s16x4,__builtin_amdgcn_ds_read_tr16_b64_v4i16((__attribute__((address_space(3))) v4i16_t*)p)); }
__device__ __forceinline__ float rowmax(const f32x16&p0,const f32x16&p1){
  float a=max3f(p0[0],p0[1],p1[0]),b=max3f(p0[2],p0[3],p1[1]);a=max3f(a,p1[2],p1[3]);
  #pragma unroll
  for(int r=4;r<16;r+=4){a=max3f(a,p0[r],p0[r+1]);b=max3f(b,p0[r+2],p0[r+3]);a=max3f(a,p1[r],p1[r+1]);b=max3f(b,p1[r+2],p1[r+3]);}
  const float m=max2f(a,b);
  auto rr=__builtin_amdgcn_permlane32_swap(__float_as_uint(m),__float_as_uint(m),false,false);
  return max2f(__uint_as_float(rr[0]),__uint_as_float(rr[1]));
}
__device__ __forceinline__ void pv(f32x16*o,int vb,bf16x8 pa0,bf16x8 pa1,bf16x8 pa2,bf16x8 pa3){
  #pragma unroll
  for(int d0=0;d0<2;++d0){s16x4 lo[4],hi[4];
    #pragma unroll
    for(int ks=0;ks<4;++ks){
      asm volatile("ds_read_b64_tr_b16 %0,%1 offset:%c2":"=&v"(lo[ks]):"v"(vb),"i"(d0*4096+ks*1024):"memory");
      asm volatile("ds_read_b64_tr_b16 %0,%1 offset:%c2":"=&v"(hi[ks]):"v"(vb),"i"(d0*4096+ks*1024+512):"memory");}
    asm volatile("s_waitcnt lgkmcnt(0)":::"memory");SBAR();
    #define PK(k) (bf16x8){lo[k][0],lo[k][1],lo[k][2],lo[k][3],hi[k][0],hi[k][1],hi[k][2],hi[k][3]}
    o[d0]=__builtin_amdgcn_mfma_f32_32x32x16_bf16(pa0,PK(0),o[d0],0,0,0);
    o[d0]=__builtin_amdgcn_mfma_f32_32x32x16_bf16(pa1,PK(1),o[d0],0,0,0);
    o[d0]=__builtin_amdgcn_mfma_f32_32x32x16_bf16(pa2,PK(2),o[d0],0,0,0);
    o[d0]=__builtin_amdgcn_mfma_f32_32x32x16_bf16(pa3,PK(3),o[d0],0,0,0);
    #undef PK
  }
}

#ifndef ATTN_STORE16
#define ATTN_STORE16(p,v) (*(u32x4*)(p)=(v))
#endif
template<int THRL,bool P2> __device__ __forceinline__ void attn_unit(int b,int qc,int kc,int vc,int oc,int qb,const bf16*Q,const bf16*__restrict__ K,const bf16*__restrict__ V,bf16*O,char*shm,float&mref,float&lref){
  int tid_=threadIdx.x; asm volatile("":"+v"(tid_));     const int tid=tid_,lane=tid&63,r32=lane&31,hi=lane>>5; const int wid=__builtin_amdgcn_readfirstlane(tid>>6);
  const long rowbase=(long)b*SEQ; const int q0=qb*QB;
  const bf16*Qw=Q+(rowbase+q0+wid*QBLK)*PQ+qc;
  const bf16*Kh=K+rowbase*PQ+kc,*Vh=V+rowbase*PQ+vc;
  const unsigned lds0=(unsigned)(uintptr_t)shm;
  float*wsf=(float*)(shm+LDS_WS)+wid*64;
  const bf16*ksrc=Kh+(long)lane*PQ+wid*8;
  const bf16*vsrc=Vh+(long)(16*(wid&3)+(lane>>2))*PQ+(wid>>2)*32+(lane&3)*8;
  const unsigned kdst=lds0+LDS_K+wid*1024, vdst=lds0+LDS_V+wid*1024;
  #define DMA_K(t,slot) glds16(ksrc+(long)(t)*KVBLK*PQ,(unsigned)__builtin_amdgcn_readfirstlane(kdst+(slot)))
  #define DMA_V(t,slot) glds16(vsrc+(long)(t)*KVBLK*PQ,(unsigned)__builtin_amdgcn_readfirstlane(vdst+(slot)))
  const int vb0=(int)(lds0+LDS_V)+((lane>>4)&1)*32+(lane&3)*8+(4*hi+((lane&15)>>2))*64;
  const char*Kbase=shm+LDS_K; bf16x8 kf[8];
  const lds_cptr shm3=(lds_cptr)shm; const lds_cptr kp0=shm3+LDS_K+hi*1024+r32*16; const lds_cptr vp0=shm3+LDS_V+((lane>>4)&1)*32+(lane&3)*8+(4*hi+((lane&15)>>2))*64;
  const int NT=(q0+QB)/KVBLK;
  DMA_K(0,0);DMA_V(0,0);DMA_K(1,SLOTB);
  bf16x8 qr[4];
  #pragma unroll
  for(int d0=0;d0<4;++d0)qr[d0]=*reinterpret_cast<const bf16x8*>(&Qw[(long)r32*PQ+d0*16+hi*8]);
  float mhat=0.f,l_reg=0.f;f32x16 o[2];o[0]=f32x16{};o[1]=f32x16{};f32x16 negm=f32x16{};asm volatile("":"+v"(negm));
  if(P2){ mhat=mref;
    _Pragma("unroll") for(int r=0;r<16;++r)negm[r]=-mhat; asm volatile("":"+v"(negm)); }
  const int qrel=wid*QBLK+r32;
  #define CMASK(P0,P1,t) do{int jb_=(t)-(NT-4); if(jb_>=0)cmask(P0,P1,jb_,qrel,hi);}while(0)
  bool resc=false;
  #define START(P0,P1) do{ resc=false; \
    if(!P2){ const float rm=rowmax(P0,P1); const float dl=rm; mhat=fadd_s(mhat,dl); \
      _Pragma("unroll") for(int r=0;r<16;++r){P0[r]=fsub_s(P0[r],dl);P1[r]=fsub_s(P1[r],dl);} \
      _Pragma("unroll") for(int r=0;r<16;++r)negm[r]=-mhat; asm volatile("":"+v"(negm)); } \
    _Pragma("unroll") for(int r=0;r<16;++r)P0[r]=__builtin_amdgcn_exp2f(P0[r]); }while(0)
  #define RESC() do{ if(resc){ asm volatile("s_waitcnt lgkmcnt(0)":::"memory"); \
      _Pragma("unroll") for(int d_=0;d_<2;++d_) _Pragma("unroll") for(int r=0;r<16;++r)o[d_][r]*=wsf[crow(r,hi)]; } }while(0)
  f32x16 pA0,pA1,pB0,pB1;
  int sl_prev=0,sl_cur=0,sl_next=SLOTB;
  #define ROT() do{sl_prev=sl_cur;sl_cur=sl_next;sl_next=(sl_next==(NSLOT-1)*SLOTB)?0:sl_next+SLOTB;}while(0)
  DMA_K(2,2*SLOTB);
  WAIT_BAR(3);
  qkt(pA0,pA1,Kbase,qr,negm,r32,hi);asm volatile("s_nop 15\n\ts_nop 7":"+v"(pA0),"+v"(pA1));CMASK(pA0,pA1,0);
  START(pA0,pA1);
  _Pragma("unroll") for(int r=0;r<16;++r)pA1[r]=__builtin_amdgcn_exp2f(pA1[r]);
  WAIT_BAR(0);
  DMA_K(3,0);DMA_V(1,SLOTB);
  ROT();
  kload8(kf,kp0+sl_cur);
  WAIT_BAR(2);
  s16x4 vlo[8],vhi[8]; u32x4 pw0,pw1,pw2,pw3;
  #define PKW(P,B) cvtpk_s(P[B],P[B+1])
  #define PAF(k) __builtin_bit_cast(bf16x8,pw##k)
  #define VFR(i) (bf16x8){vlo[i][0],vlo[i][1],vlo[i][2],vlo[i][3],vhi[i][0],vhi[i][1],vhi[i][2],vhi[i][3]}
  #define PIN(x) asm volatile("":"+v"(x))
  #define MX3(a,b,c) __builtin_fmaxf(__builtin_fmaxf((a),(b)),(c))
  #define GAPA(MF,A0,A1,A2,A3,W0,W1,PW) do{ MF; if(!P2){ sacc+=A0; sacc+=A1; sacc+=A2; sacc+=A3; PIN(sacc); } W0; W1; PIN(PW); SBAR(); }while(0)
  #define EX(v) __builtin_amdgcn_exp2f(v)
  #define GAPB(MF,X,B) do{ MF; X[B]=EX(X[B]); X[B+1]=EX(X[B+1]); X[B+2]=EX(X[B+2]); X[B+3]=EX(X[B+3]); PIN(X); SBAR(); }while(0)
  #define VRD(i) do{ vlo[i]=vtr(vp_+(((i)>>2)*4096+((i)&3)*1024)); vhi[i]=vtr(vp_+(((i)>>2)*4096+((i)&3)*1024+512)); }while(0)
  #define KRD(G,j) do{ if(G){ kload2(kf,kp0+sl_next,j); SBAR(); } }while(0)
  #define STEP(C0,C1,P0,P1,t,GK,GV,GL) do{ SBAR(); \
    const lds_cptr vp_=vp0+sl_prev; \
    VRD(0); SBAR(); float sacc=(P0[0]+P0[1]); \
    GAPA(C0=__builtin_amdgcn_mfma_f32_32x32x16_bf16(kf[0],qr[0],negm,0,0,0), P0[2],P0[3],P0[4],P0[5],     pw0[0]=PKW(P0,0), pw0[1]=PKW(P0,2), pw0); \
    VRD(4); SBAR(); GAPA(C1=__builtin_amdgcn_mfma_f32_32x32x16_bf16(kf[1],qr[0],negm,0,0,0), P0[6],P0[7],P0[8],P0[9],     pw0[2]=PKW(P0,4), pw0[3]=PKW(P0,6), pw0); \
    VRD(1); SBAR(); GAPA(C0=__builtin_amdgcn_mfma_f32_32x32x16_bf16(kf[2],qr[1],C0,0,0,0),   P0[10],P0[11],P0[12],P0[13], pw1[0]=PKW(P0,8), pw1[1]=PKW(P0,10), pw1); \
    VRD(5); SBAR(); GAPA(C1=__builtin_amdgcn_mfma_f32_32x32x16_bf16(kf[3],qr[1],C1,0,0,0),   P0[14],P0[15],P1[0],P1[1],   pw1[2]=PKW(P0,12),pw1[3]=PKW(P0,14), pw1); \
    VRD(2); SBAR(); GAPA(C0=__builtin_amdgcn_mfma_f32_32x32x16_bf16(kf[4],qr[2],C0,0,0,0),   P1[2],P1[3],P1[4],P1[5],     pw2[0]=PKW(P1,0), pw2[1]=PKW(P1,2), pw2); \
    VRD(6); SBAR(); GAPA(C1=__builtin_amdgcn_mfma_f32_32x32x16_bf16(kf[5],qr[2],C1,0,0,0),   P1[6],P1[7],P1[8],P1[9],     pw2[2]=PKW(P1,4), pw2[3]=PKW(P1,6), pw2); \
    VRD(3); SBAR(); GAPA(C0=__builtin_amdgcn_mfma_f32_32x32x16_bf16(kf[6],qr[3],C0,0,0,0),   P1[10],P1[11],P1[12],P1[13], pw3[0]=PKW(P1,8), pw3[1]=PKW(P1,10), pw3); \
    VRD(7); SBAR(); GAPA(C1=__builtin_amdgcn_mfma_f32_32x32x16_bf16(kf[7],qr[3],C1,0,0,0),   P1[14],P1[15],0.f,0.f,       pw3[2]=PKW(P1,12),pw3[3]=PKW(P1,14), pw3); \
    if(!P2)l_reg+=sacc; \
    if(GK){DMA_K((t)+3,sl_cur);} if(GV){DMA_V((t)+1,sl_next);} \
    CMASK(C0,C1,t); \
    if(!P2){ float a=MX3(C0[0],C0[1],C1[0]),b=MX3(C0[2],C0[3],C1[1]); a=MX3(a,C1[2],C1[3]); \
      _Pragma("unroll") for(int r=4;r<16;r+=4){a=MX3(a,C0[r],C0[r+1]);b=MX3(b,C0[r+2],C0[r+3]);a=MX3(a,C1[r],C1[r+1]);b=MX3(b,C1[r+2],C1[r+3]);} \
      float rm=__builtin_fmaxf(a,b); { auto rr=__builtin_amdgcn_permlane32_swap(__float_as_uint(rm),__float_as_uint(rm),false,false); rm=__builtin_fmaxf(__uint_as_float(rr[0]),__uint_as_float(rr[1])); } \
      resc=false; \
      if(__builtin_expect(__any(rm>(float)THRL),0)){ const float dl=__builtin_fmaxf(rm,0.f); mhat+=dl; \
        _Pragma("unroll") for(int r=0;r<16;++r){C0[r]-=dl;C1[r]-=dl;} \
        _Pragma("unroll") for(int r=0;r<16;++r)negm[r]=-mhat; asm volatile("":"+v"(negm)); \
        const float f=__builtin_amdgcn_exp2f(-dl); l_reg*=f; if(hi==0)wsf[r32]=f; resc=true; } } \
    SBAR(); \
    GAPB(o[0]=__builtin_amdgcn_mfma_f32_32x32x16_bf16(PAF(0),VFR(0),o[0],0,0,0), C0,0); \
    GAPB(o[1]=__builtin_amdgcn_mfma_f32_32x32x16_bf16(PAF(0),VFR(4),o[1],0,0,0), C0,4); \
    KRD(GL,0); GAPB(o[0]=__builtin_amdgcn_mfma_f32_32x32x16_bf16(PAF(1),VFR(1),o[0],0,0,0), C0,8); \
    KRD(GL,1); GAPB(o[1]=__builtin_amdgcn_mfma_f32_32x32x16_bf16(PAF(1),VFR(5),o[1],0,0,0), C0,12); \
    KRD(GL,2); GAPB(o[0]=__builtin_amdgcn_mfma_f32_32x32x16_bf16(PAF(2),VFR(2),o[0],0,0,0), C1,0); \
    KRD(GL,3); GAPB(o[1]=__builtin_amdgcn_mfma_f32_32x32x16_bf16(PAF(2),VFR(6),o[1],0,0,0), C1,4); \
    GAPB(o[0]=__builtin_amdgcn_mfma_f32_32x32x16_bf16(PAF(3),VFR(3),o[0],0,0,0), C1,8); \
    GAPB(o[1]=__builtin_amdgcn_mfma_f32_32x32x16_bf16(PAF(3),VFR(7),o[1],0,0,0), C1,12); \
    }while(0)
  int t=1;
  #undef CMASK
  #define CMASK(P0,P1,t) do{}while(0)
  for(;t+5<NT;t+=2){
    STEP(pB0,pB1,pA0,pA1,t,true,true,true);     WAIT_BAR(2); RESC(); ROT();
    STEP(pA0,pA1,pB0,pB1,t+1,true,true,true);   WAIT_BAR(2); RESC(); ROT();
  }
  #undef CMASK
  #define CMASK(P0,P1,t) do{int jb_=(t)-(NT-4); if(jb_>=0)cmask(P0,P1,jb_,qrel,hi);}while(0)
  #define ENDW(tt) do{ if((tt)+3<NT){WAIT_BAR(2);} else if((tt)+2<NT){WAIT_BAR(1);} else {WAIT_BAR(0);} }while(0)
  for(;t+1<NT;t+=2){
    STEP(pB0,pB1,pA0,pA1,t,(t+3<NT),(t+1<NT),(t+1<NT));       ENDW(t);   RESC(); ROT();
    STEP(pA0,pA1,pB0,pB1,t+1,(t+4<NT),(t+2<NT),(t+2<NT));     ENDW(t+1); RESC(); ROT();
  }
  STEP(pB0,pB1,pA0,pA1,NT-1,false,false,false); RESC();
  { float sacc=pB0[0]+pB0[1]; _Pragma("unroll") for(int r=2;r<16;++r)sacc+=pB0[r]; _Pragma("unroll") for(int r=0;r<16;++r)sacc+=pB1[r]; if(!P2)l_reg+=sacc;
    pw0=(u32x4){PKW(pB0,0),PKW(pB0,2),PKW(pB0,4),PKW(pB0,6)};pw1=(u32x4){PKW(pB0,8),PKW(pB0,10),PKW(pB0,12),PKW(pB0,14)};pw2=(u32x4){PKW(pB1,0),PKW(pB1,2),PKW(pB1,4),PKW(pB1,6)};pw3=(u32x4){PKW(pB1,8),PKW(pB1,10),PKW(pB1,12),PKW(pB1,14)};
    SBAR(); pv(o,vb0+sl_cur,PAF(0),PAF(1),PAF(2),PAF(3)); }
  #undef PKW
  #undef PAF
  #undef VFR
  #undef PIN
  #undef MX3
  #undef GAPA
  #undef GAPB
  #undef EX
  #undef VRD
  #undef KRD
  #undef STEP
  #undef ENDW
  if(!P2){auto rr=__builtin_amdgcn_permlane32_swap(__float_as_uint(l_reg),__float_as_uint(l_reg),false,false);l_reg=__uint_as_float(rr[0])+__uint_as_float(rr[1]); mref=mhat; lref=l_reg;}
  else l_reg=lref;
  if(hi==0)wsf[32+r32]=l_reg;asm volatile("s_waitcnt lgkmcnt(0)":::"memory");
  float rli[16];
  #pragma unroll
  for(int r=0;r<16;++r)rli[r]=__builtin_amdgcn_rcpf(wsf[32+crow(r,hi)]);
  bf16*Ow=O+(rowbase+q0+wid*QBLK)*PO+oc;
  { bf16*stg=(bf16*)(shm+LDS_OST)+wid*2048;
    #pragma unroll
    for(int r=0;r<16;++r){const int orow=crow(r,hi);
      #pragma unroll
      for(int d0=0;d0<2;++d0)stg[orow*64+d0*32+r32]=__float2bfloat16(o[d0][r]*rli[r]);}
    asm volatile("s_waitcnt lgkmcnt(0)":::"memory");
    #pragma unroll
    for(int i=0;i<4;++i){const int row=i*8+(lane>>3),ch=lane&7; const u32x4 v=*(const u32x4*)(stg+row*64+ch*8); ATTN_STORE16(Ow+(long)row*PO+ch*8,v);} }
  asm volatile("s_waitcnt lgkmcnt(0)\n\ts_barrier":::"memory");
  #undef DMA_K
  #undef DMA_V
  #undef CMASK
  #undef START
  #undef RESC
  #undef ROT
}
constexpr int ATTN_LDS_BYTES=LDS_BYTES;
struct AttnTensors { const bf16* Q; const bf16* K; const bf16* V; bf16* O; };
struct AttnUnit { int bh; int qb; };
struct StaticOrder {
  int vcu;
  __device__ __forceinline__ explicit StaticOrder(int grid,int block):vcu((grid%8==0)?(block%8)*(grid/8)+block/8:block),G(grid){}
  int G;
  __device__ __forceinline__ bool next(int i,AttnUnit&u)const{ const int n=i*G+vcu; if(n>=1024)return false; const int ii=n>>8,v=n&255,s=v&15; u.bh=(ii>>1)*16+(v>>4); u.qb=(ii&1)?31-s:s; return true;   const int k=0; u.qb=(k==0)?s:(k==1)?15-s:(k==2)?16+s:31-s; return true; }
  __device__ __forceinline__ void a_ready(const AttnUnit&)const{}
  __device__ __forceinline__ void done(const AttnUnit&)const{}
};
template<class Sched,int THRL=8> __device__ __forceinline__ void attn_phase(char*lds,const AttnTensors&T,const Sched&S){
  AttnUnit u;
  for(int i=0;S.next(i,u);++i){ S.a_ready(u); { const int bb=u.bh>>4,hc=u.bh&15; float mr_=0.f,lr_=0.f; attn_unit<THRL,false>(bb,hc*64,hc*64,(hc>>1)*128,(hc*2)*64,u.qb,T.Q,T.K,T.V,T.O,lds,mr_,lr_); int bb2=bb,hc2=hc,qb2=u.qb; asm volatile("":"+s"(bb2),"+s"(hc2),"+s"(qb2));     attn_unit<THRL,true>(bb2,hc2*64,hc2*64,(hc2>>1)*128+64,(hc2*2+1)*64,qb2,T.Q,T.K,T.V,T.O,lds,mr_,lr_); } S.done(u); }
}
#undef SBAR
#undef WAIT_BAR
}
#include <hip/hip_cooperative_groups.h>
namespace cg = cooperative_groups;
constexpr int NWAVES = 8;
#ifndef MK_N_LAUNCHES
#define MK_N_LAUNCHES 1
#endif
#ifndef MK_DUP
#define MK_DUP 0
#endif
#ifndef MK_YBF16
#define MK_YBF16 1
#endif
#ifndef MK_S5BF
#define MK_S5BF 1
#endif
#ifndef MK_XCCMAP
#define MK_XCCMAP 0
#endif
#ifndef MK_USE_CG
#define MK_USE_CG 0
#endif
constexpr int NPHASE = 15;
constexpr int BATCH = 2, T = 8192, D = 2048, FF = 5632, M = BATCH * T;
constexpr int AW = 1024, NG = 64, NP = 64, HC = 16, NCOND = 9 * D;
constexpr int CL = 32, NCH = T / CL;
constexpr float LN_EPS = 1e-5f, RMS_EPS = 1e-5f;
constexpr float DN_ALPHA = 1.18920711500272107f;
constexpr float LAMBDA_INIT = 0.2f;
constexpr size_t MiB = 1u << 20;
constexpr size_t WS_MOD = 1 * MiB, WS_LBR = 1 * MiB + 256 * 1024, WS_LBI = WS_LBR + 16384, WS_LCR = WS_LBI + 16384, WS_LCI = WS_LCR + 16384;
constexpr size_t WS_STATS = 3 * MiB, WS_Y3 = 402 * MiB;
constexpr size_t WS_BBR = 2 * MiB, WS_BBI = 2 * MiB + 256 * 1024;
constexpr size_t WS_W13A = 4 * MiB, WS_W2A = 48 * MiB, WS_W13B = 70 * MiB, WS_W2B = 114 * MiB, WS_WIN = 136 * MiB, WS_WOUT = 152 * MiB, WS_GLU = 160 * MiB;
constexpr size_t WS_U = 162 * MiB, WS_ACT = 226 * MiB;
constexpr size_t WS_Q = 226 * MiB, WS_K = 258 * MiB, WS_V = 290 * MiB, WS_S = 322 * MiB, WS_ST = 386 * MiB;
constexpr size_t WS_OATT = 402 * MiB, WS_CAT = 466 * MiB, WS_CARRY = 530 * MiB, WS_G = WS_Q, WS_END = 546 * MiB;
constexpr int RING_OFF = 0, RING_BYTES = 131072, MISC_OFF = RING_BYTES + 320, LDS_BYTES = 147456;
constexpr size_t CTL_ZERO_BYTES = 65536;

#define GAS __attribute__((address_space(1)))
#define LAS __attribute__((address_space(3)))
typedef unsigned short bf16;
typedef unsigned v4u __attribute__((ext_vector_type(4)));
typedef unsigned v2u __attribute__((ext_vector_type(2)));
typedef float f32x4 __attribute__((ext_vector_type(4)));
#define LDS_WAIT() asm volatile("s_waitcnt lgkmcnt(0)" ::: "memory")
__device__ __forceinline__ unsigned f2bf(float f) { unsigned u = __builtin_bit_cast(unsigned, f); return (u + 0x7fffu + ((u >> 16) & 1u)) >> 16; }
typedef float fr_f2 __attribute__((ext_vector_type(2))); typedef __bf16 fr_bf2 __attribute__((ext_vector_type(2)));
__device__ __forceinline__ unsigned pk2(float lo, float hi) { const fr_f2 v = {lo, hi}; return __builtin_bit_cast(unsigned, __builtin_convertvector(v, fr_bf2)); }
__device__ __forceinline__ float bflo(unsigned w) { return __uint_as_float(w << 16); }
__device__ __forceinline__ float bfhi(unsigned w) { return __uint_as_float(w & 0xffff0000u); }

struct Frame {
    LAS unsigned char* lds;
    int tid, lane, wave, vcu, G;
    float* out; unsigned char* ws;
};
__device__ __forceinline__ const float* inp(int i) {
    unsigned long long p;
    asm volatile("s_load_dwordx2 %0, %1, %2\n\ts_waitcnt lgkmcnt(0)" : "=s"(p) : "s"(__builtin_amdgcn_kernarg_segment_ptr()), "i"(8 * i));
    return (const float*)p;
}
__device__ __forceinline__ float wave_sum(float v) {
#pragma unroll
    for (int o = 1; o < 64; o <<= 1) v += __shfl_xor(v, o);
    return v;
}
__device__ __forceinline__ void p0_transpose_item(const float* W, int K, int N, bf16* WT, int k0, int n0, int drow0, LAS float* scr, int lane) {
#pragma unroll 8
    for (int i = 0; i < 32; ++i) { const int kk = 2 * i + (lane >> 5); scr[kk * 33 + (lane & 31)] = W[(size_t)(k0 + kk) * N + n0 + (lane & 31)]; }
    LDS_WAIT(); asm volatile("" ::: "memory");
    const int c = lane & 7;
#pragma unroll
    for (int j = 0; j < 4; ++j) { const int n = (lane >> 3) + 8 * j; const LAS float* s = scr + (8 * c) * 33 + n;
        v4u o; o.x = pk2(s[0 * 33], s[1 * 33]); o.y = pk2(s[2 * 33], s[3 * 33]); o.z = pk2(s[4 * 33], s[5 * 33]); o.w = pk2(s[6 * 33], s[7 * 33]);
        *(GAS v4u*)(WT + (size_t)(drow0 + n) * K + k0 + 8 * c) = o; }
    LDS_WAIT(); asm volatile("" ::: "memory");
}
__device__ __forceinline__ void p0_convert(Frame& F, const float* W, int K, int N, bf16* WT, int mode, int r) {
    LAS float* scr = (LAS float*)(F.lds + RING_OFF + F.wave * 16384);
    const int nblk = N / 32, kb = r / nblk, nb = r % nblk, n0 = 32 * nb;
    const int drow0 = mode == 0 ? n0 : (256 * (n0 >> 7) + (n0 & 127) + (mode == 2 ? 128 : 0));
    p0_transpose_item(W, K, N, WT, 64 * kb, n0, drow0, scr, F.lane);
}
struct CvtItem { const float* W; bf16* WT; int K, N, k0, drow0; };
#define CVT_CASE(cnt, inpidx, Kv, Nv, wsoff, mode) if (r < (cnt)) { constexpr int nblk = (Nv) / 32; const int kb = r / nblk, nb = r - kb * nblk, n0 = 32 * nb; \
    c.W = inp(inpidx) + (size_t)(64 * kb) * (Nv) + n0; c.WT = (bf16*)(F.ws + (wsoff)); c.K = (Kv); c.N = (Nv); c.k0 = 64 * kb; \
    c.drow0 = (mode) == 0 ? n0 : (256 * (n0 >> 7) + (n0 & 127) + ((mode) == 2 ? 128 : 0)); return true; } r -= (cnt);
__device__ __forceinline__ bool p0_decode(Frame& F, int it, CvtItem& c) {
    constexpr int I_F = (D / 64) * (FF / 32), I_IN = (D / 64) * (4096 / 32), I_OUT = (D / 64) * (D / 32), I_GLU = (1024 / 64) * (1024 / 32);
    constexpr int NITEMS = 6 * I_F + I_IN + I_OUT + I_GLU;
    if (it >= NITEMS) return false;
    int r = it;
    CVT_CASE(I_F, 4, D, FF, WS_W13A, 1)
    CVT_CASE(I_F, 5, D, FF, WS_W13A, 2)
    CVT_CASE(I_F, 6, FF, D, WS_W2A, 0)
    CVT_CASE(I_F, 24, D, FF, WS_W13B, 1)
    CVT_CASE(I_F, 25, D, FF, WS_W13B, 2)
    CVT_CASE(I_F, 26, FF, D, WS_W2B, 0)
    CVT_CASE(I_IN, 7, D, 4096, WS_WIN, 0)
    CVT_CASE(I_OUT, 23, D, D, WS_WOUT, 0)
    CVT_CASE(I_GLU, 21, 1024, 1024, WS_GLU, 0)
    return false;
}
__device__ __forceinline__ void p0_load(const CvtItem& c, int lane, float (&v)[32]) {
    const float* p = c.W + (size_t)(lane >> 5) * c.N + (lane & 31);
#pragma unroll
    for (int i = 0; i < 32; ++i) v[i] = p[(size_t)(2 * i) * c.N];
}
__device__ __forceinline__ void p0_store(const CvtItem& c, int lane, const float (&v)[32], LAS float* scr) {
#pragma unroll
    for (int i = 0; i < 32; ++i) scr[(2 * i + (lane >> 5)) * 33 + (lane & 31)] = v[i];
    LDS_WAIT(); asm volatile("" ::: "memory");
    const int ch = lane & 7;
#pragma unroll
    for (int j = 0; j < 4; ++j) { const int n = (lane >> 3) + 8 * j; const LAS float* s = scr + (8 * ch) * 33 + n;
        v4u o; o.x = pk2(s[0 * 33], s[1 * 33]); o.y = pk2(s[2 * 33], s[3 * 33]); o.z = pk2(s[4 * 33], s[5 * 33]); o.w = pk2(s[6 * 33], s[7 * 33]);
        *(GAS v4u*)(c.WT + (size_t)(c.drow0 + n) * c.K + c.k0 + 8 * ch) = o; }
    LDS_WAIT(); asm volatile("" ::: "memory");
}
__device__ __forceinline__ void sincos_d(double x, double& s, double& c) {
    const double TWO_PI = 6.283185307179586476925;
    const double k = __builtin_rint(x / TWO_PI);
    const double r = x - k * TWO_PI;
    const double y = r * 0.125, y2 = y * y;
    double sy = y * (1.0 + y2 * (-1.0 / 6.0 + y2 * (1.0 / 120.0 + y2 * (-1.0 / 5040.0 + y2 * (1.0 / 362880.0 + y2 * (-1.0 / 39916800.0 + y2 * (1.0 / 6227020800.0)))))));
    double cy = 1.0 + y2 * (-0.5 + y2 * (1.0 / 24.0 + y2 * (-1.0 / 720.0 + y2 * (1.0 / 40320.0 + y2 * (-1.0 / 3628800.0 + y2 * (1.0 / 479001600.0 + y2 * (-1.0 / 87178291200.0)))))));
#pragma unroll
    for (int i = 0; i < 3; ++i) { const double s2 = 2.0 * sy * cy, c2 = cy * cy - sy * sy; sy = s2; cy = c2; }
    s = sy; c = cy;
}
__device__ __forceinline__ double exp_d(double x) {
    const double LN2 = 0.693147180559945309417, k = __builtin_rint(x / LN2), r = (x - k * LN2) * 0.0625, r2 = r;
    double p = 1.0 + r2 * (1.0 + r2 * (0.5 + r2 * (1.0 / 6.0 + r2 * (1.0 / 24.0 + r2 * (1.0 / 120.0 + r2 * (1.0 / 720.0 + r2 * (1.0 / 5040.0 + r2 * (1.0 / 40320.0))))))));
#pragma unroll
    for (int i = 0; i < 4; ++i) p = p * p;
    return __builtin_ldexp(p, (int)k);
}
__device__ __forceinline__ void p0_prologue(Frame& F) {
    const float* c = inp(1); const float* w_cond = inp(2); const float* b_cond = inp(3);
    float* mod = (float*)(F.ws + WS_MOD);
    __syncthreads();
    {
        LAS float* sc = (LAS float*)(F.lds);
        LAS float* red = (LAS float*)(F.lds + 16384);
        for (int i = F.tid; i < 2 * D; i += NWAVES * 64) { const float a = c[i]; sc[i] = a * __builtin_amdgcn_rcpf(1.f + __builtin_amdgcn_exp2f(-1.44269504089f * a)); }
        __syncthreads();
        const int r = F.lane / 18, c4 = F.lane - 18 * r;
        for (int slab = blockIdx.x; slab < NCOND / 72; slab += F.G) {
            if (r < 3) {
                f32x4 a0 = (f32x4){0.f, 0.f, 0.f, 0.f}, a1 = (f32x4){0.f, 0.f, 0.f, 0.f};
                const int kb = F.wave * 256;
                const float* wp = w_cond + (size_t)(kb + r) * NCOND + slab * 72 + 4 * c4;
#pragma unroll 8
                for (int k = r; k < 256; k += 3) { const f32x4 w = *(const f32x4*)wp; wp += 3 * (size_t)NCOND; const float s0 = sc[kb + k], s1 = sc[D + kb + k]; a0 += w * s0; a1 += w * s1; }
                LAS f32x4* rp = (LAS f32x4*)(red + ((F.wave * 3 + r) * 2) * 72 + 4 * c4); rp[0] = a0; rp[18] = a1;
            }
            __syncthreads();
            if (F.tid < 144) { const int b = F.tid / 72, col = F.tid - 72 * b; float sum = 0.f;
#pragma unroll
                for (int p2 = 0; p2 < 24; ++p2) sum += red[(p2 * 2 + b) * 72 + col];
                mod[b * NCOND + slab * 72 + col] = sum + b_cond[slab * 72 + col]; }
            __syncthreads();
        }
    }
    {
        const int gt = F.vcu * (NWAVES * 64) + F.tid;
        if (gt < NG * NP) {
            const int g = gt >> 6;
            const double are = (double)inp(13)[gt], aim = (double)inp(14)[gt];
            const double dt = exp_d((double)inp(15)[g]);
            const double mag = exp_d(are * dt); double sn, cs; sincos_d(aim * dt, sn, cs);
            const double lr = mag * cs, li = mag * sn, nr = lr - 1.0, ni = li, den = are * are + aim * aim;
            const double cre = (nr * are + ni * aim) / den, cim = (ni * are - nr * aim) / den;
            ((float*)(F.ws + WS_LBR))[gt] = (float)lr; ((float*)(F.ws + WS_LBI))[gt] = (float)li;
            double pr = lr, pi = li;
#pragma unroll
            for (int i = 0; i < 5; ++i) { const double a = pr * pr - pi * pi, b = 2.0 * pr * pi; pr = a; pi = b; }
            ((float*)(F.ws + WS_LCR))[gt] = (float)pr; ((float*)(F.ws + WS_LCI))[gt] = (float)pi;
            const float* bre = inp(16) + (size_t)gt * HC; const float* bim = inp(17) + (size_t)gt * HC;
            float* obr = (float*)(F.ws + WS_BBR) + (size_t)gt * HC; float* obi = (float*)(F.ws + WS_BBI) + (size_t)gt * HC;
#pragma unroll
            for (int h = 0; h < HC; ++h) { const double br = bre[h], bi = bim[h]; obr[h] = (float)(cre * br - cim * bi); obi[h] = (float)(cre * bi + cim * br); }
        }
    }
    __syncthreads();
    {
        const int gw = F.vcu * NWAVES + F.wave, NGW = F.G * NWAVES;
        LAS float* scr = (LAS float*)(F.lds + RING_OFF + F.wave * 16384);
        CvtItem cur, nxt; float v[32], vn[32];
        bool has = p0_decode(F, gw, cur);
        if (has) p0_load(cur, F.lane, v);
        for (int it = gw; has; it += NGW) {
            const bool hn = p0_decode(F, it + NGW, nxt);
            if (hn) p0_load(nxt, F.lane, vn);
            p0_store(cur, F.lane, v, scr);
            cur = nxt; has = hn;
#pragma unroll
            for (int i = 0; i < 32; ++i) v[i] = vn[i];
        }
    }
}
__device__ __forceinline__ void modulate_phase(Frame& F, const float* X, const float* shift, const float* scale, bf16* U) {
    const int gw = F.vcu * NWAVES + F.wave, NGW = F.G * NWAVES;
    f32x4 sc1[8], sh[8], cur[8], nxt[8]; int cb = -1;
    if (gw < M) { const GAS f32x4* xr = (const GAS f32x4*)(X + (size_t)gw * D) + F.lane;
#pragma unroll
        for (int j = 0; j < 8; ++j) cur[j] = xr[64 * j]; }
    for (int m = gw; m < M; m += NGW) {
        const int b = m >> 13, mn = m + NGW;
        if (b != cb) { cb = b;
#pragma unroll
            for (int j = 0; j < 8; ++j) { const int col = 256 * j + 4 * F.lane; sc1[j] = *(const f32x4*)(scale + (size_t)b * NCOND + col) + 1.0f; sh[j] = *(const f32x4*)(shift + (size_t)b * NCOND + col); } }
        if (mn < M) { const GAS f32x4* xr = (const GAS f32x4*)(X + (size_t)mn * D) + F.lane;
#pragma unroll
            for (int j = 0; j < 8; ++j) nxt[j] = xr[64 * j]; }
        GAS v2u* ur = (GAS v2u*)(U + (size_t)m * D) + F.lane;
#pragma unroll
        for (int j = 0; j < 8; ++j) { const f32x4 o = cur[j] * sc1[j] + sh[j]; v2u w; w.x = pk2(o.x, o.y); w.y = pk2(o.z, o.w); ur[64 * j] = w; }
#pragma unroll
        for (int j = 0; j < 8; ++j) cur[j] = nxt[j];
    }
}
template <bool WRITE_U>
__device__ __forceinline__ void ln_phase(Frame& F, const float* Y, float* Xo, const float* lng, const float* lnb, const float* shift, const float* scale, bf16* U) {
    const int gw = F.vcu * NWAVES + F.wave, NGW = F.G * NWAVES;
    for (int m = gw; m < M; m += NGW) {
        const int b = m >> 13;
        const GAS f32x4* yr = (const GAS f32x4*)(Y + (size_t)m * D) + F.lane;
        f32x4 v[8]; float s = 0.f;
#pragma unroll
        for (int j = 0; j < 8; ++j) { v[j] = yr[64 * j]; s += (v[j].x + v[j].y) + (v[j].z + v[j].w); }
        const float mean = wave_sum(s) * (1.f / D); float s2 = 0.f;
#pragma unroll
        for (int j = 0; j < 8; ++j) { v[j] = v[j] - mean; s2 += (v[j].x * v[j].x + v[j].y * v[j].y) + (v[j].z * v[j].z + v[j].w * v[j].w); }
        const float rstd = 1.f / sqrtf(wave_sum(s2) * (1.f / D) + LN_EPS);
        GAS f32x4* xo = (GAS f32x4*)(Xo + (size_t)m * D) + F.lane;
        GAS v2u* ur = (GAS v2u*)(U + (size_t)m * D) + F.lane;
#pragma unroll
        for (int j = 0; j < 8; ++j) { const int col = 256 * j + 4 * F.lane;
            const f32x4 g4 = *(const f32x4*)(lng + col), b4 = *(const f32x4*)(lnb + col);
            const f32x4 o = v[j] * rstd * g4 + b4; xo[64 * j] = o;
            if (WRITE_U) { const f32x4 sc = *(const f32x4*)(scale + (size_t)b * NCOND + col), sh = *(const f32x4*)(shift + (size_t)b * NCOND + col);
                const f32x4 uu = o * (sc + 1.0f) + sh; v2u w; w.x = pk2(uu.x, uu.y); w.y = pk2(uu.z, uu.w); ur[64 * j] = w; } }
    }
}
template <bool FINAL, bool YBF>
__device__ __forceinline__ void ln_phase2(Frame& F, const void* Y, float* stats, float* Xo, const float* lng, const float* lnb, const float* shift, const float* scale, bf16* U) {
    constexpr int W = YBF ? 8 : 4, NJ = 32 / W, NR = YBF ? 4 : 8;
    const int gw = F.vcu * NWAVES + F.wave, NGW = F.G * NWAVES;
    f32x4 Gp[8], Bp[8]; int cb = -1;
    v4u cur[NR], nxt[NR];
    if (gw < M) {
#pragma unroll
        for (int j = 0; j < NR; ++j) cur[j] = YBF ? *(const GAS v4u*)((const bf16*)Y + (size_t)gw * D + 512 * j + 8 * F.lane) : *(const GAS v4u*)((const float*)Y + (size_t)gw * D + 256 * j + 4 * F.lane); }
    for (int m = gw; m < M; m += NGW) {
        const int b = m >> 13, mn = m + NGW;
        if ((FINAL && cb < 0) || (!FINAL && b != cb)) { cb = b;
#pragma unroll
            for (int j = 0; j < NJ; ++j)
#pragma unroll
                for (int q = 0; q < W / 4; ++q) { const int col = 64 * W * j + W * F.lane + 4 * q, jq = j * (W / 4) + q;
                    const f32x4 g4 = *(const f32x4*)(lng + col), b4 = *(const f32x4*)(lnb + col);
                    if (FINAL) { Gp[jq] = g4; Bp[jq] = b4; }
                    else { const f32x4 s1 = *(const f32x4*)(scale + (size_t)b * NCOND + col) + 1.0f, sh = *(const f32x4*)(shift + (size_t)b * NCOND + col); Gp[jq] = g4 * s1; Bp[jq] = b4 * s1 + sh; } } }
        if (mn < M) {
#pragma unroll
            for (int j = 0; j < NR; ++j) nxt[j] = YBF ? *(const GAS v4u*)((const bf16*)Y + (size_t)mn * D + 512 * j + 8 * F.lane) : *(const GAS v4u*)((const float*)Y + (size_t)mn * D + 256 * j + 4 * F.lane); }
        float v[32]; float s = 0.f;
#pragma unroll
        for (int j = 0; j < NR; ++j) { const v4u w = cur[j];
            if (YBF) { v[8 * j + 0] = bflo(w.x); v[8 * j + 1] = bfhi(w.x); v[8 * j + 2] = bflo(w.y); v[8 * j + 3] = bfhi(w.y); v[8 * j + 4] = bflo(w.z); v[8 * j + 5] = bfhi(w.z); v[8 * j + 6] = bflo(w.w); v[8 * j + 7] = bfhi(w.w); }
            else { v[4 * j + 0] = __uint_as_float(w.x); v[4 * j + 1] = __uint_as_float(w.y); v[4 * j + 2] = __uint_as_float(w.z); v[4 * j + 3] = __uint_as_float(w.w); } }
#pragma unroll
        for (int i = 0; i < 32; i += 4) s += (v[i] + v[i + 1]) + (v[i + 2] + v[i + 3]);
        const float mean = wave_sum(s) * (1.f / D); float s2 = 0.f;
#pragma unroll
        for (int i = 0; i < 32; ++i) { v[i] -= mean; s2 += v[i] * v[i]; }
        const float rstd = 1.f / sqrtf(wave_sum(s2) * (1.f / D) + LN_EPS);
        if (!FINAL && F.lane == 0) { stats[2 * (size_t)m] = mean; stats[2 * (size_t)m + 1] = rstd; }
#pragma unroll
        for (int j = 0; j < NJ; ++j) { const int col = 64 * W * j + W * F.lane;
            float o[W];
#pragma unroll
            for (int q = 0; q < W / 4; ++q) { const int jq = j * (W / 4) + q;
#pragma unroll
                for (int i = 0; i < 4; ++i) o[4 * q + i] = v[W * j + 4 * q + i] * rstd * Gp[jq][i] + Bp[jq][i]; }
            if (FINAL) {
#pragma unroll
                for (int q = 0; q < W / 4; ++q) *(GAS f32x4*)(Xo + (size_t)m * D + col + 4 * q) = (f32x4){o[4 * q], o[4 * q + 1], o[4 * q + 2], o[4 * q + 3]};
            } else {
                if (YBF) { v4u w; w.x = pk2(o[0], o[1]); w.y = pk2(o[2], o[3]); w.z = pk2(o[W - 4], o[W - 3]); w.w = pk2(o[W - 2], o[W - 1]); *(GAS v4u*)(U + (size_t)m * D + col) = w; }
                else { v2u w; w.x = pk2(o[0], o[1]); w.y = pk2(o[2], o[3]); *(GAS v2u*)(U + (size_t)m * D + col) = w; }
            } }
#pragma unroll
        for (int j = 0; j < NR; ++j) cur[j] = nxt[j];
    }
}
template <bool FINAL, bool YBF>
__device__ __forceinline__ void ln_phase3(Frame& F, const void* Y, float* stats, float* Xo, const float* lng, const float* lnb, const float* shift, const float* scale, bf16* U) {
    constexpr int W = YBF ? 8 : 4, NJ = 32 / W, NR = YBF ? 4 : 8;
    const int gw = F.vcu * NWAVES + F.wave, NGW = F.G * NWAVES;
    LAS f32x4* tG = (LAS f32x4*)(F.lds); LAS f32x4* tB = tG + 1024;
    { const int col = 4 * F.tid; const f32x4 g4 = *(const f32x4*)(lng + col), b4 = *(const f32x4*)(lnb + col);
#pragma unroll
      for (int b = 0; b < 2; ++b) {
          if (FINAL) { tG[b * 512 + F.tid] = g4; tB[b * 512 + F.tid] = b4; }
          else { const f32x4 s1 = *(const f32x4*)(scale + (size_t)b * NCOND + col) + 1.0f, sh = *(const f32x4*)(shift + (size_t)b * NCOND + col); tG[b * 512 + F.tid] = g4 * s1; tB[b * 512 + F.tid] = b4 * s1 + sh; } } }
    __syncthreads();
#define LN3_LOAD(dst, mm) do { _Pragma("unroll") for (int j = 0; j < NR; ++j) dst[j] = YBF ? *(const GAS v4u*)((const bf16*)Y + (size_t)(mm) * D + 512 * j + 8 * F.lane) : *(const GAS v4u*)((const float*)Y + (size_t)(mm) * D + 256 * j + 4 * F.lane); } while (0)
    v4u cur[NR], nx1[NR], nxt[NR];
    if (gw < M) LN3_LOAD(cur, gw);
    if (gw + NGW < M) LN3_LOAD(nx1, gw + NGW);
    for (int m = gw; m < M; m += NGW) {
        const int b = m >> 13, mn = m + 2 * NGW;
        if (mn < M) LN3_LOAD(nxt, mn);
        float v[32]; float s = 0.f;
#pragma unroll
        for (int j = 0; j < NR; ++j) { const v4u w = cur[j];
            if (YBF) { v[8 * j + 0] = bflo(w.x); v[8 * j + 1] = bfhi(w.x); v[8 * j + 2] = bflo(w.y); v[8 * j + 3] = bfhi(w.y); v[8 * j + 4] = bflo(w.z); v[8 * j + 5] = bfhi(w.z); v[8 * j + 6] = bflo(w.w); v[8 * j + 7] = bfhi(w.w); }
            else { v[4 * j + 0] = __uint_as_float(w.x); v[4 * j + 1] = __uint_as_float(w.y); v[4 * j + 2] = __uint_as_float(w.z); v[4 * j + 3] = __uint_as_float(w.w); } }
#pragma unroll
        for (int i = 0; i < 32; i += 4) s += (v[i] + v[i + 1]) + (v[i + 2] + v[i + 3]);
        const float mean = wave_sum(s) * (1.f / D); float s2 = 0.f;
#pragma unroll
        for (int i = 0; i < 32; ++i) { v[i] -= mean; s2 += v[i] * v[i]; }
        const float rstd = 1.f / sqrtf(wave_sum(s2) * (1.f / D) + LN_EPS);
        if (!FINAL && F.lane == 0) { stats[2 * (size_t)m] = mean; stats[2 * (size_t)m + 1] = rstd; }
#pragma unroll
        for (int j = 0; j < NJ; ++j) { const int col = 64 * W * j + W * F.lane;
            float o[W];
#pragma unroll
            for (int q = 0; q < W / 4; ++q) { const f32x4 G4 = tG[b * 512 + (col >> 2) + q], B4 = tB[b * 512 + (col >> 2) + q];
#pragma unroll
                for (int i = 0; i < 4; ++i) o[4 * q + i] = v[W * j + 4 * q + i] * rstd * G4[i] + B4[i]; }
            if (FINAL) {
#pragma unroll
                for (int q = 0; q < W / 4; ++q) *(GAS f32x4*)(Xo + (size_t)m * D + col + 4 * q) = (f32x4){o[4 * q], o[4 * q + 1], o[4 * q + 2], o[4 * q + 3]};
            } else {
                if (YBF) { v4u w; w.x = pk2(o[0], o[1]); w.y = pk2(o[2], o[3]); w.z = pk2(o[W - 4], o[W - 3]); w.w = pk2(o[W - 2], o[W - 1]); *(GAS v4u*)(U + (size_t)m * D + col) = w; }
                else { v2u w; w.x = pk2(o[0], o[1]); w.y = pk2(o[2], o[3]); *(GAS v2u*)(U + (size_t)m * D + col) = w; }
            } }
#pragma unroll
        for (int j = 0; j < NR; ++j) { cur[j] = nx1[j]; nx1[j] = nxt[j]; }
    }
#undef LN3_LOAD
    __syncthreads();
}
typedef float s5x4 __attribute__((ext_vector_type(4)));
template <bool OUT>
__device__ __forceinline__ void s5_scan(Frame& F) {
    const int lane = F.lane, j = lane & 15, q = lane >> 4;
    const int gw = F.vcu * NWAVES + F.wave, NGW = F.G * NWAVES;
    const float* BBR = (const float*)(F.ws + WS_BBR); const float* BBI = (const float*)(F.ws + WS_BBI);
    const float* LBR = (const float*)(F.ws + WS_LBR); const float* LBI = (const float*)(F.ws + WS_LBI);
    const float* S = (const float*)(F.ws + WS_S);
    for (int it = gw; it < BATCH * NG * (NCH / 16); it += NGW) {
        const int bg = it >> 4, w = it & 15, b = bg >> 6, g = bg & 63;
        s5x4 ainr[4], aini[4], lr[4], li[4], aoutr[4], aouti[4], hr[4], hi[4];
#pragma unroll
        for (int sb = 0; sb < 4; ++sb) {
            ainr[sb] = *(const s5x4*)(BBR + (size_t)(g * 64 + 16 * sb + j) * HC + 4 * q);
            aini[sb] = *(const s5x4*)(BBI + (size_t)(g * 64 + 16 * sb + j) * HC + 4 * q);
            lr[sb] = *(const s5x4*)(LBR + g * 64 + 16 * sb + 4 * q); li[sb] = *(const s5x4*)(LBI + g * 64 + 16 * sb + 4 * q);
            if (OUT) { aoutr[sb] = *(const s5x4*)(inp(18) + (size_t)(g * 16 + j) * NP + 16 * sb + 4 * q);
                       aouti[sb] = -*(const s5x4*)(inp(19) + (size_t)(g * 16 + j) * NP + 16 * sb + 4 * q); }
        }
        const int ch = 16 * w + j;
        const size_t stoff = ((size_t)(bg * NCH + ch) * 2) * NP + 4 * q;
        if (OUT) { const float* CY = (const float*)(F.ws + WS_CARRY) + stoff;
#pragma unroll
            for (int sb = 0; sb < 4; ++sb) { hr[sb] = *(const s5x4*)(CY + 16 * sb); hi[sb] = *(const s5x4*)(CY + NP + 16 * sb); } }
        else {
#pragma unroll
            for (int sb = 0; sb < 4; ++sb) { hr[sb] = (s5x4){0.f, 0.f, 0.f, 0.f}; hi[sb] = (s5x4){0.f, 0.f, 0.f, 0.f}; } }
        const size_t row0 = (size_t)b * T + (size_t)ch * CL;
        const float* sp = S + row0 * 1024 + g * 16 + 4 * q;
        s5x4 dsk = (s5x4){0.f, 0.f, 0.f, 0.f}; if (OUT) dsk = *(const s5x4*)(inp(20) + g * 16 + 4 * q);
        bf16* gp = (bf16*)(F.ws + WS_G) + row0 * 1024 + g * 16 + 4 * q;
        s5x4 uv = *(const s5x4*)sp;
        for (int t = 0; t < CL; ++t) {
            const s5x4 un = *(const s5x4*)(sp + (size_t)(t + 1 < CL ? t + 1 : t) * 1024);
            s5x4 tr[4], ti[4];
#pragma unroll
            for (int sb = 0; sb < 4; ++sb) { tr[sb] = lr[sb] * hr[sb] - li[sb] * hi[sb]; ti[sb] = lr[sb] * hi[sb] + li[sb] * hr[sb]; }
#pragma unroll
            for (int kk = 0; kk < 4; ++kk)
#pragma unroll
                for (int sb = 0; sb < 4; ++sb) { tr[sb] = __builtin_amdgcn_mfma_f32_16x16x4f32(ainr[sb][kk], uv[kk], tr[sb], 0, 0, 0);
                                                 ti[sb] = __builtin_amdgcn_mfma_f32_16x16x4f32(aini[sb][kk], uv[kk], ti[sb], 0, 0, 0); }
#pragma unroll
            for (int sb = 0; sb < 4; ++sb) { hr[sb] = tr[sb]; hi[sb] = ti[sb]; }
            if (OUT) {
                s5x4 y0 = dsk * uv, y1 = (s5x4){0.f, 0.f, 0.f, 0.f};
#pragma unroll
                for (int sb = 0; sb < 4; ++sb)
#pragma unroll
                    for (int r = 0; r < 4; ++r) { y0 = __builtin_amdgcn_mfma_f32_16x16x4f32(aoutr[sb][r], hr[sb][r], y0, 0, 0, 0);
                                                  y1 = __builtin_amdgcn_mfma_f32_16x16x4f32(aouti[sb][r], hi[sb][r], y1, 0, 0, 0); }
                const s5x4 y = y0 + y1; float o[4];
#pragma unroll
                for (int i = 0; i < 4; ++i) { const float v = y[i], z = 1.5957691216f * (v + 0.044715f * v * v * v);
                    o[i] = v * __builtin_amdgcn_rcpf(1.f + __builtin_amdgcn_exp2f(-1.44269504089f * z)); }
                v2u wv; wv.x = pk2(o[0], o[1]); wv.y = pk2(o[2], o[3]);
                *(GAS v2u*)(gp + (size_t)t * 1024) = wv;
            }
            uv = un;
        }
        if (!OUT) { float* ST = (float*)(F.ws + WS_ST) + stoff;
#pragma unroll
            for (int sb = 0; sb < 4; ++sb) { *(s5x4*)(ST + 16 * sb) = hr[sb]; *(s5x4*)(ST + NP + 16 * sb) = hi[sb]; } }
    }
}
typedef short s5h8 __attribute__((ext_vector_type(8)));
__device__ __forceinline__ s5h8 s5_pack8(s5x4 a, s5x4 b) { v4u w; w.x = pk2(a[0], a[1]); w.y = pk2(a[2], a[3]); w.z = pk2(b[0], b[1]); w.w = pk2(b[2], b[3]); return __builtin_bit_cast(s5h8, w); }
template <bool OUT>
__device__ __forceinline__ void s5_scan_bf(Frame& F) {
    const int lane = F.lane, j = lane & 15, q = lane >> 4, qc = 8 * (q & 1);
    const bool lopart = q >= 2;
    const int gw = F.vcu * NWAVES + F.wave, NGW = F.G * NWAVES;
    const float* BBR = (const float*)(F.ws + WS_BBR); const float* BBI = (const float*)(F.ws + WS_BBI);
    const float* LBR = (const float*)(F.ws + WS_LBR); const float* LBI = (const float*)(F.ws + WS_LBI);
    const float* S = (const float*)(F.ws + WS_S);
    for (int it = gw; it < BATCH * NG * (NCH / 16); it += NGW) {
        const int bg = it >> 4, w = it & 15, b = bg >> 6, g = bg & 63;
        s5h8 ainr[4], aini[4], aoutr[2], aouti[2]; s5x4 lr[4], li[4], hr[4], hi[4];
#pragma unroll
        for (int sb = 0; sb < 4; ++sb) {
            const float* pr = BBR + (size_t)(g * 64 + 16 * sb + j) * HC + qc; const float* pi = BBI + (size_t)(g * 64 + 16 * sb + j) * HC + qc;
            ainr[sb] = s5_pack8(*(const s5x4*)pr, *(const s5x4*)(pr + 4)); aini[sb] = s5_pack8(*(const s5x4*)pi, *(const s5x4*)(pi + 4));
            lr[sb] = *(const s5x4*)(LBR + g * 64 + 16 * sb + 4 * q); li[sb] = *(const s5x4*)(LBI + g * 64 + 16 * sb + 4 * q);
        }
        if (OUT) {
#pragma unroll
            for (int sp = 0; sp < 2; ++sp) {
                const float* cr = inp(18) + (size_t)(g * 16 + j) * NP + 32 * sp + 4 * q; const float* ci = inp(19) + (size_t)(g * 16 + j) * NP + 32 * sp + 4 * q;
                aoutr[sp] = s5_pack8(*(const s5x4*)cr, *(const s5x4*)(cr + 16)); aouti[sp] = s5_pack8(-*(const s5x4*)ci, -*(const s5x4*)(ci + 16));
            }
        }
        const int ch = 16 * w + j;
        const size_t stoff = ((size_t)(bg * NCH + ch) * 2) * NP + 4 * q;
        if (OUT) { const float* CY = (const float*)(F.ws + WS_CARRY) + stoff;
#pragma unroll
            for (int sb = 0; sb < 4; ++sb) { hr[sb] = *(const s5x4*)(CY + 16 * sb); hi[sb] = *(const s5x4*)(CY + NP + 16 * sb); } }
        else {
#pragma unroll
            for (int sb = 0; sb < 4; ++sb) { hr[sb] = (s5x4){0.f, 0.f, 0.f, 0.f}; hi[sb] = (s5x4){0.f, 0.f, 0.f, 0.f}; } }
        const size_t row0 = (size_t)b * T + (size_t)ch * CL;
        const float* sp8 = S + row0 * 1024 + g * 16 + qc;
        const float* sp4 = S + row0 * 1024 + g * 16 + 4 * q;
        s5x4 dsk = (s5x4){0.f, 0.f, 0.f, 0.f}; if (OUT) dsk = *(const s5x4*)(inp(20) + g * 16 + 4 * q);
        bf16* gp = (bf16*)(F.ws + WS_G) + row0 * 1024 + g * 16 + 4 * q;
        s5x4 ua = *(const s5x4*)sp8, ub = *(const s5x4*)(sp8 + 4), u4 = (s5x4){0.f, 0.f, 0.f, 0.f}; if (OUT) u4 = *(const s5x4*)sp4;
        for (int t = 0; t < CL; ++t) {
            const size_t tn = (size_t)(t + 1 < CL ? t + 1 : t) * 1024;
            const s5x4 na = *(const s5x4*)(sp8 + tn), nb = *(const s5x4*)(sp8 + tn + 4); s5x4 n4 = u4; if (OUT) n4 = *(const s5x4*)(sp4 + tn);
            s5h8 ufrag;
            { const s5h8 uh = s5_pack8(ua, ub); const v4u hw = __builtin_bit_cast(v4u, uh);
              s5x4 ra, rb;
              ra[0] = ua[0] - bflo(hw.x); ra[1] = ua[1] - bfhi(hw.x); ra[2] = ua[2] - bflo(hw.y); ra[3] = ua[3] - bfhi(hw.y);
              rb[0] = ub[0] - bflo(hw.z); rb[1] = ub[1] - bfhi(hw.z); rb[2] = ub[2] - bflo(hw.w); rb[3] = ub[3] - bfhi(hw.w);
              const s5h8 ul = s5_pack8(ra, rb); ufrag = lopart ? ul : uh; }
            s5x4 tr[4], ti[4];
#pragma unroll
            for (int sb = 0; sb < 4; ++sb) { tr[sb] = lr[sb] * hr[sb] - li[sb] * hi[sb]; ti[sb] = lr[sb] * hi[sb] + li[sb] * hr[sb]; }
#pragma unroll
            for (int sb = 0; sb < 4; ++sb) { hr[sb] = __builtin_amdgcn_mfma_f32_16x16x32_bf16(ainr[sb], ufrag, tr[sb], 0, 0, 0);
                                             hi[sb] = __builtin_amdgcn_mfma_f32_16x16x32_bf16(aini[sb], ufrag, ti[sb], 0, 0, 0); }
            if (OUT) {
                s5x4 y0 = dsk * u4, y1 = (s5x4){0.f, 0.f, 0.f, 0.f};
#pragma unroll
                for (int sp = 0; sp < 2; ++sp) { y0 = __builtin_amdgcn_mfma_f32_16x16x32_bf16(aoutr[sp], s5_pack8(hr[2 * sp], hr[2 * sp + 1]), y0, 0, 0, 0);
                                                 y1 = __builtin_amdgcn_mfma_f32_16x16x32_bf16(aouti[sp], s5_pack8(hi[2 * sp], hi[2 * sp + 1]), y1, 0, 0, 0); }
                const s5x4 y = y0 + y1; float o[4];
#pragma unroll
                for (int i = 0; i < 4; ++i) { const float v = y[i], z = 1.5957691216f * (v + 0.044715f * v * v * v);
                    o[i] = v * __builtin_amdgcn_rcpf(1.f + __builtin_amdgcn_exp2f(-1.44269504089f * z)); }
                v2u wv; wv.x = pk2(o[0], o[1]); wv.y = pk2(o[2], o[3]);
                *(GAS v2u*)(gp + (size_t)t * 1024) = wv;
            }
            ua = na; ub = nb; u4 = n4;
        }
        if (!OUT) { float* ST = (float*)(F.ws + WS_ST) + stoff;
#pragma unroll
            for (int sb = 0; sb < 4; ++sb) { *(s5x4*)(ST + 16 * sb) = hr[sb]; *(s5x4*)(ST + NP + 16 * sb) = hi[sb]; } }
    }
}
__device__ __forceinline__ void s5_carry(Frame& F) {
    LAS float* tot = (LAS float*)(F.lds);
    for (int bg = F.vcu; bg < BATCH * NG; bg += F.G) {
        const int g = bg & 63, p = F.lane, w = F.wave;
        const float Lr = ((const float*)(F.ws + WS_LCR))[g * 64 + p], Li = ((const float*)(F.ws + WS_LCI))[g * 64 + p];
        const float* __restrict__ ST = (const float*)(F.ws + WS_ST) + ((size_t)bg * NCH + 32 * w) * 2 * NP + p;
        float* __restrict__ CY = (float*)(F.ws + WS_CARRY) + ((size_t)bg * NCH + 32 * w) * 2 * NP + p;
        float sr[32], si[32];
#pragma unroll
        for (int c = 0; c < 32; ++c) { sr[c] = ST[(size_t)c * 2 * NP]; si[c] = ST[(size_t)c * 2 * NP + NP]; }
        float cr = 0.f, ci = 0.f;
#pragma unroll
        for (int c = 0; c < 32; ++c) { const float tr = sr[c], ti = si[c]; sr[c] = cr; si[c] = ci; const float nr = Lr * cr - Li * ci + tr, ni = Lr * ci + Li * cr + ti; cr = nr; ci = ni; }
        tot[(w * 2 + 0) * 64 + p] = cr; tot[(w * 2 + 1) * 64 + p] = ci;
        __syncthreads();
        float Pr = Lr, Pi = Li;
#pragma unroll
        for (int i = 0; i < 5; ++i) { const float a = Pr * Pr - Pi * Pi, b2 = 2.f * Pr * Pi; Pr = a; Pi = b2; }
        float ar = 0.f, ai = 0.f;
        for (int v = 0; v < w; ++v) { const float tr = tot[(v * 2 + 0) * 64 + p], ti = tot[(v * 2 + 1) * 64 + p]; const float nr = Pr * ar - Pi * ai + tr, ni = Pr * ai + Pi * ar + ti; ar = nr; ai = ni; }
        float qr = 1.f, qi = 0.f;
#pragma unroll
        for (int c = 0; c < 32; ++c) { CY[(size_t)c * 2 * NP] = sr[c] + qr * ar - qi * ai; CY[(size_t)c * 2 * NP + NP] = si[c] + qr * ai + qi * ar;
            const float nr = qr * Lr - qi * Li, ni = qr * Li + qi * Lr; qr = nr; qi = ni; }
        __syncthreads();
    }
}
__device__ __forceinline__ void attn_combine(Frame& F) {
    const int gw = F.vcu * NWAVES + F.wave, NGW = F.G * NWAVES;
    float d1 = 0.f, d2 = 0.f;
    { const float a = inp(8)[F.lane] * inp(9)[F.lane], b = inp(10)[F.lane] * inp(11)[F.lane]; d1 = wave_sum(a); d2 = wave_sum(b); }
    const float lam = __expf(d1) - __expf(d2) + LAMBDA_INIT;
    const int h = F.lane >> 3, e0 = (F.lane & 7) * 16;
    float gsub[16];
#pragma unroll
    for (int i = 0; i < 16; ++i) gsub[i] = inp(12)[e0 + i] * (1.0f - LAMBDA_INIT);
    const bf16* OA = (const bf16*)(F.ws + WS_OATT); bf16* CAT = (bf16*)(F.ws + WS_CAT);
    v4u a0, a1, b0, b1, na0, na1, nb0, nb1;
    if (gw < M) { const GAS v4u* p0 = (const GAS v4u*)(OA + (size_t)gw * 2048 + (h * 2 + 0) * 128 + e0); const GAS v4u* p1 = (const GAS v4u*)(OA + (size_t)gw * 2048 + (h * 2 + 1) * 128 + e0);
        a0 = p0[0]; a1 = p0[1]; b0 = p1[0]; b1 = p1[1]; }
    for (int m = gw; m < M; m += NGW) {
        const int mn = m + NGW;
        if (mn < M) { const GAS v4u* p0 = (const GAS v4u*)(OA + (size_t)mn * 2048 + (h * 2 + 0) * 128 + e0); const GAS v4u* p1 = (const GAS v4u*)(OA + (size_t)mn * 2048 + (h * 2 + 1) * 128 + e0);
            na0 = p0[0]; na1 = p0[1]; nb0 = p1[0]; nb1 = p1[1]; }
        float o[16];
        o[0] = bflo(a0.x) - lam * bflo(b0.x); o[1] = bfhi(a0.x) - lam * bfhi(b0.x); o[2] = bflo(a0.y) - lam * bflo(b0.y); o[3] = bfhi(a0.y) - lam * bfhi(b0.y);
        o[4] = bflo(a0.z) - lam * bflo(b0.z); o[5] = bfhi(a0.z) - lam * bfhi(b0.z); o[6] = bflo(a0.w) - lam * bflo(b0.w); o[7] = bfhi(a0.w) - lam * bfhi(b0.w);
        o[8] = bflo(a1.x) - lam * bflo(b1.x); o[9] = bfhi(a1.x) - lam * bfhi(b1.x); o[10] = bflo(a1.y) - lam * bflo(b1.y); o[11] = bfhi(a1.y) - lam * bfhi(b1.y);
        o[12] = bflo(a1.z) - lam * bflo(b1.z); o[13] = bfhi(a1.z) - lam * bfhi(b1.z); o[14] = bflo(a1.w) - lam * bflo(b1.w); o[15] = bfhi(a1.w) - lam * bfhi(b1.w);
        float ss = 0.f;
#pragma unroll
        for (int i = 0; i < 16; ++i) ss += o[i] * o[i];
        ss += __shfl_xor(ss, 1); ss += __shfl_xor(ss, 2); ss += __shfl_xor(ss, 4);
        const float rs = 1.f / sqrtf(ss * (1.f / 128.f) + RMS_EPS);
        v4u w0, w1;
        w0.x = pk2(o[0] * rs * gsub[0], o[1] * rs * gsub[1]); w0.y = pk2(o[2] * rs * gsub[2], o[3] * rs * gsub[3]); w0.z = pk2(o[4] * rs * gsub[4], o[5] * rs * gsub[5]); w0.w = pk2(o[6] * rs * gsub[6], o[7] * rs * gsub[7]);
        w1.x = pk2(o[8] * rs * gsub[8], o[9] * rs * gsub[9]); w1.y = pk2(o[10] * rs * gsub[10], o[11] * rs * gsub[11]); w1.z = pk2(o[12] * rs * gsub[12], o[13] * rs * gsub[13]); w1.w = pk2(o[14] * rs * gsub[14], o[15] * rs * gsub[15]);
        GAS v4u* po = (GAS v4u*)(CAT + (size_t)m * 2048 + h * 128 + e0); po[0] = w0; po[1] = w1;
        a0 = na0; a1 = na1; b0 = nb0; b1 = nb1;
    }
}

#define RLX_AGENT __ATOMIC_RELAXED, __HIP_MEMORY_SCOPE_AGENT
#define XB_TMO      128
#define XB_XCNT(j)  (256  + 64 * (j))
#define XB_XSUB(j)  (1280 + 64 * (j))
#define XB_XGEN(j)  (2304 + 64 * (j))
#define XB_TOP      3328
#define XB_TOPGEN   3392
#define XCD_BAR_WORDS 3456
#define XB_SPIN_CAP (1u << 18)

__device__ __forceinline__ unsigned xb_ld(unsigned* p)              { return __hip_atomic_load(p, __ATOMIC_RELAXED, __HIP_MEMORY_SCOPE_AGENT); }
__device__ __forceinline__ unsigned xb_add(unsigned* p, unsigned v) { return __hip_atomic_fetch_add(p, v, __ATOMIC_RELAXED, __HIP_MEMORY_SCOPE_AGENT); }
__device__ __forceinline__ unsigned xb_xcc_id() { return (unsigned)__builtin_amdgcn_s_getreg((3 << 11) | 20) & 0xFu; }
#define XB_SPIN(cond, bar) do { unsigned _sp = 0; while (cond) { __builtin_amdgcn_s_sleep(1); \
    if ((++_sp & 255u) == 0u) { if (xb_ld(&(bar)[XB_TMO])) break; if (_sp > XB_SPIN_CAP) { atomicAdd(&(bar)[XB_TMO], 1u); break; } } } } while (0)

struct XcdBarrier {
    unsigned* bar; unsigned x;
    volatile LAS unsigned* st;
};

__device__ __forceinline__ XcdBarrier xcd_barrier_post(unsigned* bar, volatile LAS unsigned* st) {
    XcdBarrier b; b.bar = bar; b.x = xb_xcc_id(); b.st = st;
    if (threadIdx.x == 0) (void)xb_add(&bar[XB_XCNT(b.x)], 1u);
    return b;
}
__device__ __forceinline__ void xcd_barrier_complete(unsigned* bar, unsigned x, unsigned& nloc, unsigned& nx) {
    const unsigned G = gridDim.x * gridDim.y * gridDim.z;
    unsigned sum, cnt, mine, sp = 0u;
    for (;;) {
        sum = 0u; cnt = 0u; mine = 0u;
#pragma unroll
        for (unsigned j = 0; j < 16; ++j) { const unsigned c = xb_ld(&bar[XB_XCNT(j)]); sum += c; cnt += (c > 0u) ? 1u : 0u; mine = (j == x) ? c : mine; }
        if (sum == G) break;
        __builtin_amdgcn_s_sleep(1);
        if ((++sp & 255u) == 0u) { if (xb_ld(&bar[XB_TMO])) break; if (sp > XB_SPIN_CAP) { atomicAdd(&bar[XB_TMO], 1u); break; } }
    }
    nloc = mine > 0u ? mine : 1u; nx = cnt > 0u ? cnt : 1u;
}

__device__ __forceinline__ void xcd_barrier(const XcdBarrier& b) {
    asm volatile("s_waitcnt vmcnt(0)" ::: "memory");
    __syncthreads();
    if (threadIdx.x == 0) {
        unsigned* bar = b.bar;
        __builtin_amdgcn_s_waitcnt(0);
        unsigned nloc = b.st[0], nx = b.st[1];
        if (nloc == 0u) { xcd_barrier_complete(bar, b.x, nloc, nx); b.st[0] = nloc; b.st[1] = nx; }
        const unsigned old = xb_add(&bar[XB_XSUB(b.x)], 1u);
        const unsigned gen = old / nloc;
        if (old + 1u == (gen + 1u) * nloc) {
            __builtin_amdgcn_fence(__ATOMIC_RELEASE, "agent");
            asm volatile("s_waitcnt vmcnt(0)" ::: "memory");
            const unsigned og = xb_add(&bar[XB_TOP], 1u);
            const unsigned tg = og / nx;
            if (og + 1u == (tg + 1u) * nx) xb_add(&bar[XB_TOPGEN], 1u);
            else XB_SPIN(xb_ld(&bar[XB_TOPGEN]) == tg, bar);
            __builtin_amdgcn_fence(__ATOMIC_ACQUIRE, "agent");
            xb_add(&bar[XB_XGEN(b.x)], 1u);
            asm volatile("s_waitcnt vmcnt(0)" ::: "memory");
        } else {
            XB_SPIN(xb_ld(&bar[XB_XGEN(b.x)]) == gen, bar);
            __builtin_amdgcn_fence(__ATOMIC_ACQUIRE, "agent");
            asm volatile("s_waitcnt vmcnt(0)" ::: "memory");
        }
    }
    __syncthreads();
}
struct Args { const float* in[29]; float* out; unsigned char* ws; int ph_lo, ph_hi; };
__global__ void __launch_bounds__(NWAVES * 64, 2) mk_fwd(Args args) {
    extern __shared__ __attribute__((aligned(16))) unsigned char lds[];
    Frame F;
    F.lds = (LAS unsigned char*)lds;
    F.tid = threadIdx.x; F.lane = F.tid & 63; F.wave = __builtin_amdgcn_readfirstlane(F.tid >> 6);
    F.G = gridDim.x; { const int bx = blockIdx.x; F.vcu = (F.G % 8 == 0) ? (bx % 8) * (F.G / 8) + bx / 8 : bx; }
    F.out = args.out; F.ws = args.ws;
    unsigned char* ws = args.ws;
    const float* mod = (const float*)(ws + WS_MOD);
    bf16* U = (bf16*)(ws + WS_U); bf16* ACT = (bf16*)(ws + WS_ACT); float* STATS = (float*)(ws + WS_STATS);
    constexpr bool YBF = MK_YBF16 != 0;
    const int lo = args.ph_lo, hi = args.ph_hi;
    int cbx = blockIdx.x;
#define IN(k) (lo <= (k) && (k) < hi)
#define PH_BEGIN() do { int t_ = threadIdx.x; asm volatile("" : "+v"(t_)); F.tid = t_; F.lane = t_ & 63; F.wave = __builtin_amdgcn_readfirstlane(t_ >> 6); } while (0)
#if MK_USE_CG
#define SEAM(k) do { if (IN(k) && IN((k) + 1)) { cg::this_grid().sync(); } } while (0)
#else
    volatile LAS unsigned* MISC = (volatile LAS unsigned*)(F.lds + MISC_OFF);
    if (threadIdx.x < 32) MISC[threadIdx.x] = 0u;
    __syncthreads();
    if (lo < 0) cg::this_grid().sync();
    XcdBarrier bar; bar.bar = (unsigned*)ws; bar.x = 0; bar.st = nullptr;
    if (hi - lo > 1) bar = xcd_barrier_post((unsigned*)ws, MISC + 8);
#if MK_XCCMAP
    if (hi - lo > 1 && threadIdx.x == 0) MISC[4] = xb_add((unsigned*)ws + 8192 + 64 * xb_xcc_id(), 1u);
    __syncthreads();
#endif
#define SEAM(k) do { if (IN(k) && IN((k) + 1)) { xcd_barrier(bar); } } while (0)
#endif

    if (IN(0)) for (int rep_ = 0; rep_ <= ((MK_DUP >> 0) & 1); ++rep_) { PH_BEGIN(); p0_prologue(F); } SEAM(0);
#if MK_XCCMAP && !MK_USE_CG
    if (IN(0) && IN(1)) {
        bool okmap = (F.G % 8) == 0;
#pragma unroll
        for (int j = 0; j < 16; ++j) { const unsigned cnt = xb_ld((unsigned*)ws + 8192 + 64 * j); okmap = okmap && (cnt == (j < 8 ? (unsigned)F.G / 8u : 0u)); }
        if (okmap) { const int xr = (int)MISC[4], xx = (int)xb_xcc_id(); cbx = xr * 8 + xx; F.vcu = xx * (F.G / 8) + xr; }
    }
#endif
    if (IN(1)) for (int rep_ = 0; rep_ <= ((MK_DUP >> 1) & 1); ++rep_) { PH_BEGIN(); modulate_phase(F, inp(0), mod + 0 * D, mod + 1 * D, U); } SEAM(1);
    if (IN(2)) for (int rep_ = 0; rep_ <= ((MK_DUP >> 2) & 1); ++rep_) { PH_BEGIN();
        pg8::Gemm g{U, (const pg8::bf16_t*)(ws + WS_W13A), M, 2 * FF, D}; pg8::StaticOrder S; S.init(M, 2 * FF, F.G, cbx);
        pg8::EpiSwiGLU E{ACT, FF};
        pg8::gemm_phase<pg8::EpiSwiGLU, pg8::StaticOrder, PG8_ALIGN, PG8_SP2>(F.lds + RING_OFF, g, S, E);
    } SEAM(2);
    if (IN(3)) for (int rep_ = 0; rep_ <= ((MK_DUP >> 3) & 1); ++rep_) { PH_BEGIN();
        pg8::Gemm g{ACT, (const pg8::bf16_t*)(ws + WS_W2A), M, D, FF}; pg8::StaticOrder S; S.init(M, D, F.G, cbx);
        pg8::EpiResid2<false, YBF> E{inp(0), F.out, STATS, nullptr, nullptr, mod + 2 * D, NCOND, DN_ALPHA, 0.5f};
        pg8::gemm_phase<pg8::EpiResid2<false, YBF>, pg8::StaticOrder, PG8_ALIGN, PG8_SP2>(F.lds + RING_OFF, g, S, E);
    } SEAM(3);
    if (IN(4)) for (int rep_ = 0; rep_ <= ((MK_DUP >> 4) & 1); ++rep_) { PH_BEGIN(); ln_phase3<false, YBF>(F, F.out, STATS, nullptr, inp(27) + 0 * D, inp(28) + 0 * D, mod + 3 * D, mod + 4 * D, U); } SEAM(4);
    if (IN(5)) for (int rep_ = 0; rep_ <= ((MK_DUP >> 5) & 1); ++rep_) { PH_BEGIN();
        pg8::Gemm g{U, (const pg8::bf16_t*)(ws + WS_WIN), M, 4096, D}; pg8::StaticOrder S; S.init(M, 4096, F.G, cbx);
        pg8::EpiInProj E{(pg8::bf16_t*)(ws + WS_Q), (pg8::bf16_t*)(ws + WS_K), (pg8::bf16_t*)(ws + WS_V), (float*)(ws + WS_S), attn_body::C2};
        pg8::gemm_phase<pg8::EpiInProj, pg8::StaticOrder, PG8_ALIGN, PG8_SP2>(F.lds + RING_OFF, g, S, E);
    } SEAM(5);
    if (IN(6)) for (int rep_ = 0; rep_ <= ((MK_DUP >> 6) & 1); ++rep_) { PH_BEGIN(); if (MK_S5BF) s5_scan_bf<false>(F); else s5_scan<false>(F); } SEAM(6);
    if (IN(7)) for (int rep_ = 0; rep_ <= ((MK_DUP >> 7) & 1); ++rep_) { PH_BEGIN();
        s5_carry(F);
        const attn_body::AttnTensors AT{(const attn_body::bf16*)(ws + WS_Q), (const attn_body::bf16*)(ws + WS_K), (const attn_body::bf16*)(ws + WS_V), (attn_body::bf16*)(ws + WS_OATT)};
        const attn_body::StaticOrder S((int)F.G, cbx);
        attn_body::attn_phase<attn_body::StaticOrder>((char*)lds + RING_OFF, AT, S);
    } SEAM(7);
    if (IN(8)) for (int rep_ = 0; rep_ <= ((MK_DUP >> 8) & 1); ++rep_) { PH_BEGIN(); if (MK_S5BF) s5_scan_bf<true>(F); else s5_scan<true>(F); attn_combine(F); } SEAM(8);
    if (IN(9)) for (int rep_ = 0; rep_ <= ((MK_DUP >> 9) & 1); ++rep_) { PH_BEGIN();
        pg8::Gemm g{(const pg8::bf16_t*)(ws + WS_G), (const pg8::bf16_t*)(ws + WS_GLU), M, 1024, 1024}; pg8::StaticOrder S; S.init(M, 1024, F.G, cbx);
        pg8::EpiGLU E{(const pg8::bf16_t*)(ws + WS_G), 1024, (pg8::bf16_t*)(ws + WS_CAT) + 1024, 2048, inp(22)};
        pg8::gemm_phase<pg8::EpiGLU, pg8::StaticOrder, PG8_ALIGN, PG8_SP2>(F.lds + RING_OFF, g, S, E);
    } SEAM(9);
    if (IN(10)) for (int rep_ = 0; rep_ <= ((MK_DUP >> 10) & 1); ++rep_) { PH_BEGIN();
        pg8::Gemm g{(const pg8::bf16_t*)(ws + WS_CAT), (const pg8::bf16_t*)(ws + WS_WOUT), M, D, D}; pg8::StaticOrder S; S.init(M, D, F.G, cbx);
        pg8::EpiResid2<true, YBF> E{F.out, F.out, STATS, inp(27) + 0 * D, inp(28) + 0 * D, mod + 5 * D, NCOND, DN_ALPHA, 1.0f};
        pg8::gemm_phase<pg8::EpiResid2<true, YBF>, pg8::StaticOrder, PG8_ALIGN, PG8_SP2>(F.lds + RING_OFF, g, S, E);
    } SEAM(10);
    if (IN(11)) for (int rep_ = 0; rep_ <= ((MK_DUP >> 11) & 1); ++rep_) { PH_BEGIN(); ln_phase3<false, YBF>(F, F.out, STATS, nullptr, inp(27) + 1 * D, inp(28) + 1 * D, mod + 6 * D, mod + 7 * D, U); } SEAM(11);
    if (IN(12)) for (int rep_ = 0; rep_ <= ((MK_DUP >> 12) & 1); ++rep_) { PH_BEGIN();
        pg8::Gemm g{U, (const pg8::bf16_t*)(ws + WS_W13B), M, 2 * FF, D}; pg8::StaticOrder S; S.init(M, 2 * FF, F.G, cbx);
        pg8::EpiSwiGLU E{ACT, FF};
        pg8::gemm_phase<pg8::EpiSwiGLU, pg8::StaticOrder, PG8_ALIGN, PG8_SP2>(F.lds + RING_OFF, g, S, E);
    } SEAM(12);
    if (IN(13)) for (int rep_ = 0; rep_ <= ((MK_DUP >> 13) & 1); ++rep_) { PH_BEGIN();
        pg8::Gemm g{ACT, (const pg8::bf16_t*)(ws + WS_W2B), M, D, FF}; pg8::StaticOrder S; S.init(M, D, F.G, cbx);
        pg8::EpiResid2<true, YBF> E{F.out, (void*)(ws + WS_Y3), STATS, inp(27) + 1 * D, inp(28) + 1 * D, mod + 8 * D, NCOND, DN_ALPHA, 0.5f};
        pg8::gemm_phase<pg8::EpiResid2<true, YBF>, pg8::StaticOrder, PG8_ALIGN, PG8_SP2>(F.lds + RING_OFF, g, S, E);
    } SEAM(13);
    if (IN(14)) for (int rep_ = 0; rep_ <= ((MK_DUP >> 14) & 1); ++rep_) { PH_BEGIN(); ln_phase3<true, YBF>(F, (const void*)(ws + WS_Y3), STATS, F.out, inp(27) + 2 * D, inp(28) + 2 * D, mod, mod, U); }
#undef IN
#undef SEAM
}

extern "C" void kernel_launch(void* const* d_in, const int* in_sizes, int n_in, void* d_out, int out_size, void* d_ws, size_t ws_size, hipStream_t stream) {
    static int inited = 0;
    if (!inited) {
        if (n_in != 29 || out_size != M * D || ws_size < WS_END) { fprintf(stderr, "kernel_launch: unexpected shapes (n_in %d, out %d, ws %zu)\n", n_in, out_size, ws_size); inited = -1; return; }
        if (hipFuncSetAttribute((const void*)mk_fwd, hipFuncAttributeMaxDynamicSharedMemorySize, LDS_BYTES) != hipSuccess) { fprintf(stderr, "kernel_launch: hipFuncSetAttribute failed\n"); inited = -1; return; }
        inited = 1;
    }
    if (inited < 0) return;
    Args a{};
    for (int i = 0; i < 29; ++i) a.in[i] = (const float*)d_in[i];
    a.out = (float*)d_out; a.ws = (unsigned char*)d_ws;
#if MK_N_LAUNCHES == 1
    a.ph_lo = 0; a.ph_hi = NPHASE;
#if !MK_USE_CG
    (void)hipMemsetAsync(d_ws, 0, CTL_ZERO_BYTES, stream);
#endif
    void* kargs[] = {&a};
    const hipError_t e = hipLaunchCooperativeKernel((const void*)mk_fwd, dim3(256), dim3(NWAVES * 64), kargs, LDS_BYTES, stream);
    if (e != hipSuccess) fprintf(stderr, "kernel_launch: cooperative launch failed: %s\n", hipGetErrorString(e));
#else
    for (int ph = 0; ph < NPHASE; ++ph) { a.ph_lo = ph; a.ph_hi = ph + 1; hipLaunchKernelGGL(mk_fwd, dim3(256), dim3(NWAVES * 64), LDS_BYTES, stream, a); }
#endif
}
```

```cpp
#define MK_N_LAUNCHES 1
#define MK_ATTN_P2 1
#define MK_YBF16 1
#define MK_DUP 0
#include <hip/hip_runtime.h>
#include <cstdio>
#include <cstdint>
namespace pg8 {
#define PG8_LAS __attribute__((address_space(3)))
typedef unsigned short bf16_t;
typedef short bf16x8 __attribute__((ext_vector_type(8)));
typedef float f32x4 __attribute__((ext_vector_type(4)));
typedef unsigned u32x4 __attribute__((ext_vector_type(4)));
constexpr int BM = 256, BK = 64, HALF = 128, HTB = HALF * BK * 2  , STAGE_BYTES = 8 * HTB, NXCD = 8, WGM = 8;

__host__ __device__ __forceinline__ int lds_byte(int r, int c) { const int st = (r >> 4) * 2 + (c >> 5), rr = r & 15, cc = c & 31, ob = rr * 64 + cc * 2; return st * 1024 + (ob ^ (((ob >> 9) & 1) << 5)); }
__host__ __device__ __forceinline__ void stage_rc(int b, int& R, int& C) { const int st = b / 1024, sb = b % 1024, swz = sb ^ (((sb >> 9) & 1) << 5); R = (st >> 1) * 16 + swz / 64; C = (st & 1) * 32 + (swz % 64) / 2; }
__host__ __device__ __forceinline__ int perm32(int rho) { const int n = rho >> 4, i = rho & 15; return 8 * (i >> 2) + 4 * n + (i & 3); }

struct Unit { int pm, pn; };
struct Gemm { const bf16_t* A; const bf16_t* Bt; int M, N, K; };

struct StaticOrder {
    int nM, nN, nwg, G, c;
    __host__ __device__ void init(int M, int N, int G_, int c_) { nM = M / BM; nN = N / BM; nwg = nM * nN; G = G_; c = c_; }
    __host__ __device__ bool next(int i, Unit& u) const {
        const long L = (long)i * G + c; if (L >= nwg) return false;
        int wgid = (int)L; { const int q = nwg / NXCD, r = nwg % NXCD, xcd = wgid % NXCD, off = wgid / NXCD; wgid = (xcd < r ? xcd * (q + 1) : r * (q + 1) + (xcd - r) * q) + off; }
        const int nig = WGM * nN, gid = wgid / nig, fm = gid * WGM, gsz = (nM - fm) < WGM ? (nM - fm) : WGM;
        u.pm = fm + ((wgid % nig) % gsz); u.pn = (wgid % nig) / gsz; return true;
    }
    __device__ __forceinline__ void a_ready(const Unit&) const {}
    __device__ __forceinline__ void done(const Unit&) const {}
};

__device__ __forceinline__ unsigned cvt_pk_bf16(float lo, float hi) { unsigned r; asm volatile("v_cvt_pk_bf16_f32 %0, %1, %2" : "=v"(r) : "v"(lo), "v"(hi)); return r; }
typedef float f32x2 __attribute__((ext_vector_type(2)));
__device__ __forceinline__ f32x2 gelu_pk(f32x2 v) {
    const f32x2 av = __builtin_elementwise_abs(v), d = av * 0.2316418882f + 1.0f;
    f32x2 t; t.x = __builtin_amdgcn_rcpf(d.x); t.y = __builtin_amdgcn_rcpf(d.y);
    f32x2 q = t * 0.5307027145f + (-0.7265760135f); q = q * t + 0.7107068705f; q = q * t + (-0.142248368f); q = q * t + 0.127414796f; q = q * t;
    const f32x2 s = (v * v) * (-0.72134752044f);
    f32x2 e; e.x = __builtin_amdgcn_exp2f(s.x); e.y = __builtin_amdgcn_exp2f(s.y);
    const f32x2 m = v * (q * e), r = v - m;
    f32x2 o; o.x = v.x < 0.f ? m.x : r.x; o.y = v.y < 0.f ? m.y : r.y; return o;
}

__device__ __forceinline__ float silu_f(float a) { return a * __builtin_amdgcn_rcpf(1.f + __builtin_amdgcn_exp2f(-1.44269504089f * a)); }
__device__ __forceinline__ float sigm_f(float a) { return __builtin_amdgcn_rcpf(1.f + __builtin_amdgcn_exp2f(-1.44269504089f * a)); }
struct EpiSwiGLU {
    static constexpr bool PERM = true, AFTER_DRAIN = false;
    bf16_t* O; int ldc;
    __device__ __forceinline__ void operator()(const f32x4 (&acc)[2][2][4][2], const Unit& u, int wr, int wc, int fr, int fq) const {
        const int row0 = u.pm * BM + wr * 64 + fr, col0 = u.pn * HALF + wc * 32 + 8 * fq;
#pragma unroll
        for (int ai = 0; ai < 2; ++ai)
#pragma unroll
            for (int m = 0; m < 4; ++m) { bf16_t* rowp = O + (size_t)(row0 + ai * HALF + m * 16) * ldc + col0;
                const f32x4 a0 = acc[ai][0][m][0], a1 = acc[ai][0][m][1], b0 = acc[ai][1][m][0], b1 = acc[ai][1][m][1];
                f32x4 v0, v1;
#pragma unroll
                for (int i = 0; i < 4; ++i) { v0[i] = silu_f(a0[i]) * b0[i]; v1[i] = silu_f(a1[i]) * b1[i]; }
                u32x4 w; w.x = cvt_pk_bf16(v0[0], v0[1]); w.y = cvt_pk_bf16(v0[2], v0[3]); w.z = cvt_pk_bf16(v1[0], v1[1]); w.w = cvt_pk_bf16(v1[2], v1[3]);
                *(u32x4*)rowp = w; }
    }
};
template <bool LNRES, bool YBF> struct EpiResid2 {
    static constexpr bool PERM = true, AFTER_DRAIN = false;
    const void* res; void* out; const float* stats; const float* lng; const float* lnb; const float* gate; int gate_bstride; float alpha, coef;
    __device__ __forceinline__ void operator()(const f32x4 (&acc)[2][2][4][2], const Unit& u, int wr, int wc, int fr, int fq) const {
        const int b = u.pm >> 5;
        const int col0 = u.pn * BM + wc * 32 + 8 * fq;
        f32x4 gv[2][2], ag[2][2], ab[2][2];
#pragma unroll
        for (int bj = 0; bj < 2; ++bj)
#pragma unroll
            for (int n = 0; n < 2; ++n) { const int c = col0 + bj * HALF + 4 * n;
                gv[bj][n] = (*(const f32x4*)(gate + (size_t)b * gate_bstride + c) + 1.0f) * coef;
                if (LNRES) { ag[bj][n] = *(const f32x4*)(lng + c) * alpha; ab[bj][n] = *(const f32x4*)(lnb + c) * alpha; } }
        constexpr int MG = 2;
#pragma unroll
        for (int ai = 0; ai < 2; ++ai)
#pragma unroll
        for (int mg = 0; mg < 4 / MG; ++mg) {
            u32x4 rw[MG][2]; f32x4 rx[MG][2][2]; f32x2 st[MG];
#pragma unroll
            for (int mm = 0; mm < MG; ++mm) { const int m = mg * MG + mm; const int row = u.pm * BM + ai * HALF + wr * 64 + m * 16 + fr;
                if (LNRES) st[mm] = *(const f32x2*)(stats + 2 * (size_t)row);
#pragma unroll
                for (int bj = 0; bj < 2; ++bj) { const size_t off = (size_t)row * 2048 + col0 + bj * HALF;
                    if (LNRES && YBF) rw[mm][bj] = *(const u32x4*)((const bf16_t*)res + off);
                    else { rx[mm][bj][0] = *(const f32x4*)((const float*)res + off); rx[mm][bj][1] = *(const f32x4*)((const float*)res + off + 4); } } }
            asm volatile("" ::: "memory");
#pragma unroll
            for (int mm = 0; mm < MG; ++mm) { const int m = mg * MG + mm; const int row = u.pm * BM + ai * HALF + wr * 64 + m * 16 + fr;
                float mean = 0.f, rstd = 1.f;
                if (LNRES) { mean = st[mm].x; rstd = st[mm].y; }
#pragma unroll
                for (int bj = 0; bj < 2; ++bj) { const size_t off = (size_t)row * 2048 + col0 + bj * HALF;
                    f32x4 x0, x1;
                    if (LNRES && YBF) { const u32x4 w = rw[mm][bj];
                        x0 = (f32x4){__uint_as_float(w.x << 16), __uint_as_float(w.x & 0xffff0000u), __uint_as_float(w.y << 16), __uint_as_float(w.y & 0xffff0000u)};
                        x1 = (f32x4){__uint_as_float(w.z << 16), __uint_as_float(w.z & 0xffff0000u), __uint_as_float(w.w << 16), __uint_as_float(w.w & 0xffff0000u)}; }
                    else { x0 = rx[mm][bj][0]; x1 = rx[mm][bj][1]; }
                    f32x4 o0, o1;
                    if (LNRES) { o0 = (x0 - mean) * rstd * ag[bj][0] + ab[bj][0] + gv[bj][0] * acc[ai][bj][m][0]; o1 = (x1 - mean) * rstd * ag[bj][1] + ab[bj][1] + gv[bj][1] * acc[ai][bj][m][1]; }
                    else { o0 = x0 * alpha + gv[bj][0] * acc[ai][bj][m][0]; o1 = x1 * alpha + gv[bj][1] * acc[ai][bj][m][1]; }
                    if (YBF) { u32x4 w; w.x = cvt_pk_bf16(o0[0], o0[1]); w.y = cvt_pk_bf16(o0[2], o0[3]); w.z = cvt_pk_bf16(o1[0], o1[1]); w.w = cvt_pk_bf16(o1[2], o1[3]); *(u32x4*)((bf16_t*)out + off) = w; }
                    else { *(f32x4*)((float*)out + off) = o0; *(f32x4*)((float*)out + off + 4) = o1; } } }
            asm volatile("" ::: "memory");
        }
    }
};
struct EpiInProj {
    static constexpr bool PERM = true, AFTER_DRAIN = false;
    bf16_t* Q; bf16_t* K; bf16_t* V; float* S; float qscale;
    __device__ __forceinline__ void operator()(const f32x4 (&acc)[2][2][4][2], const Unit& u, int wr, int wc, int fr, int fq) const {
        const int t = u.pn >> 2, row0 = u.pm * BM + wr * 64 + fr, col0 = (u.pn & 3) * BM + wc * 32 + 8 * fq;
        if (t == 3) {
#pragma unroll
            for (int ai = 0; ai < 2; ++ai)
#pragma unroll
                for (int m = 0; m < 4; ++m) { float* rowp = S + (size_t)(row0 + ai * HALF + m * 16) * 1024 + col0;
#pragma unroll
                    for (int bj = 0; bj < 2; ++bj) { *(f32x4*)(rowp + bj * HALF) = acc[ai][bj][m][0]; *(f32x4*)(rowp + bj * HALF + 4) = acc[ai][bj][m][1]; } }
        } else {
            bf16_t* base = Q + (size_t)t * (size_t)(K - Q); const float sc = t == 0 ? qscale : 1.0f;
#pragma unroll
            for (int ai = 0; ai < 2; ++ai)
#pragma unroll
                for (int m = 0; m < 4; ++m) { bf16_t* rowp = base + (size_t)(row0 + ai * HALF + m * 16) * 1024 + col0;
#pragma unroll
                    for (int bj = 0; bj < 2; ++bj) { const f32x4 v0 = acc[ai][bj][m][0] * sc, v1 = acc[ai][bj][m][1] * sc;
                        u32x4 w; w.x = cvt_pk_bf16(v0[0], v0[1]); w.y = cvt_pk_bf16(v0[2], v0[3]); w.z = cvt_pk_bf16(v1[0], v1[1]); w.w = cvt_pk_bf16(v1[2], v1[3]);
                        *(u32x4*)(rowp + bj * HALF) = w; } }
        }
    }
};
struct EpiGLU {
    static constexpr bool PERM = true, AFTER_DRAIN = false;
    const bf16_t* G; int ldg; bf16_t* O; int ldo; const float* bias;
    __device__ __forceinline__ void operator()(const f32x4 (&acc)[2][2][4][2], const Unit& u, int wr, int wc, int fr, int fq) const {
        const int row0 = u.pm * BM + wr * 64 + fr, col0 = u.pn * BM + wc * 32 + 8 * fq;
        f32x4 bv[2][2];
#pragma unroll
        for (int bj = 0; bj < 2; ++bj)
#pragma unroll
            for (int n = 0; n < 2; ++n) bv[bj][n] = *(const f32x4*)(bias + col0 + bj * HALF + 4 * n);
#pragma unroll
        for (int ai = 0; ai < 2; ++ai)
#pragma unroll
            for (int m = 0; m < 4; ++m) { const int row = row0 + ai * HALF + m * 16;
#pragma unroll
                for (int bj = 0; bj < 2; ++bj) { const u32x4 gw = *(const u32x4*)(G + (size_t)row * ldg + col0 + bj * HALF);
                    const f32x4 z0 = acc[ai][bj][m][0] + bv[bj][0], z1 = acc[ai][bj][m][1] + bv[bj][1];
                    float g[8]; g[0] = __uint_as_float(gw.x << 16); g[1] = __uint_as_float(gw.x & 0xffff0000u); g[2] = __uint_as_float(gw.y << 16); g[3] = __uint_as_float(gw.y & 0xffff0000u);
                    g[4] = __uint_as_float(gw.z << 16); g[5] = __uint_as_float(gw.z & 0xffff0000u); g[6] = __uint_as_float(gw.w << 16); g[7] = __uint_as_float(gw.w & 0xffff0000u);
                    float o[8];
#pragma unroll
                    for (int i = 0; i < 4; ++i) { o[i] = g[i] * sigm_f(z0[i]); o[4 + i] = g[4 + i] * sigm_f(z1[i]); }
                    u32x4 w; w.x = cvt_pk_bf16(o[0], o[1]); w.y = cvt_pk_bf16(o[2], o[3]); w.z = cvt_pk_bf16(o[4], o[5]); w.w = cvt_pk_bf16(o[6], o[7]);
                    *(u32x4*)(O + (size_t)row * ldo + col0 + bj * HALF) = w; } }
    }
};

template <class Epi, class Sched, bool ALIGN_EPI = false, bool SP2 = false>
__device__ __forceinline__ void gemm_phase(PG8_LAS unsigned char* lds, const Gemm g, const Sched& S, const Epi& E) {
    const int tid = threadIdx.x, wid = __builtin_amdgcn_readfirstlane(tid >> 6), lane = tid & 63, wr = wid >> 2, wc = wid & 3, fr = lane & 15, fq = lane >> 4;
    const int K = g.K, nt = K / BK;
    unsigned voffA[2], voffB[2];
#pragma unroll
    for (int i = 0; i < 2; ++i) { int R, C; stage_rc(tid * 16 + i * 8192, R, C); const int Rb = Epi::PERM ? ((R & ~31) + perm32(R & 31)) : R;
        voffA[i] = (unsigned)(R * K + C) * 2u; voffB[i] = (unsigned)(Rb * K + C) * 2u; }
    const size_t kstep = (size_t)(BK * 2);
    const size_t hstep = (size_t)HALF * K * 2;
    const size_t tstep = 2 * hstep;
    const unsigned ldsw = (unsigned)wid * 1024u;
    const int aoff = lds_byte(wr * 64 + fr, fq * 8), boff = lds_byte(wc * 32 + fr, fq * 8);
#define PG8_SA(b, h) (((b) * 2 + (h)) * HTB)
#define PG8_SB(b, h) ((4 + (b) * 2 + (h)) * HTB)
#define PG8_STAGE(bufoff, gbase, voff) do { _Pragma("unroll") for (int _i = 0; _i < 2; ++_i) \
        __builtin_amdgcn_global_load_lds((const unsigned*)((const char*)(gbase) + (voff)[_i]), (PG8_LAS unsigned*)(lds + (bufoff) + ldsw + _i * 8192), 16, 0, 0); } while (0)
#define PG8_LDA(dst, b, h) do { _Pragma("unroll") for (int m = 0; m < 4; ++m) _Pragma("unroll") for (int k = 0; k < 2; ++k) dst[m][k] = *(const PG8_LAS bf16x8*)(lds + PG8_SA(b, h) + aoff + m * 2048 + k * 1024); } while (0)
#define PG8_LDB(dst, b, h) do { _Pragma("unroll") for (int n = 0; n < 2; ++n) _Pragma("unroll") for (int k = 0; k < 2; ++k) dst[n][k] = *(const PG8_LAS bf16x8*)(lds + PG8_SB(b, h) + boff + n * 2048 + k * 1024); } while (0)
#define PG8_MMA(ai, bj, At, Bt) do { __builtin_amdgcn_s_setprio(1); _Pragma("unroll") for (int m = 0; m < 4; ++m) _Pragma("unroll") for (int n = 0; n < 2; ++n) _Pragma("unroll") for (int k = 0; k < 2; ++k) \
        acc[ai][bj][m][n] = __builtin_amdgcn_mfma_f32_16x16x32_bf16(Bt[n][k], At[m][k], acc[ai][bj][m][n], 0, 0, 0); __builtin_amdgcn_s_setprio(0); } while (0)
#define PG8_WAIT_V(n) asm volatile("s_waitcnt vmcnt(" #n ")" ::: "memory")
#define PG8_WAIT_L(n) asm volatile("s_waitcnt lgkmcnt(" #n ")" ::: "memory")
#define PG8_BAR __builtin_amdgcn_s_barrier()
#define PG8_SCHED __builtin_amdgcn_sched_barrier(0)
    Unit cur, nxt; int ui = 0;
    if (!S.next(0, cur)) return;
    f32x4 acc[2][2][4][2];
#pragma unroll
    for (int a = 0; a < 2; ++a)
#pragma unroll
        for (int b = 0; b < 2; ++b)
#pragma unroll
            for (int m = 0; m < 4; ++m)
#pragma unroll
                for (int n = 0; n < 2; ++n) acc[a][b][m][n] = (f32x4){0.f, 0.f, 0.f, 0.f};
    bf16x8 At[4][2], B0[2][2], B1[2][2];
    const char* cA = (const char*)g.A + (size_t)cur.pm * tstep; const char* cB = (const char*)g.Bt + (size_t)cur.pn * tstep;
    S.a_ready(cur);
    if constexpr (SP2) {
        PG8_STAGE(PG8_SB(0, 0), cB, voffB); PG8_STAGE(PG8_SB(0, 1), cB + hstep, voffB); PG8_STAGE(PG8_SA(0, 0), cA, voffA); PG8_STAGE(PG8_SA(0, 1), cA + hstep, voffA);
        if (wr == 1) PG8_BAR;
        PG8_WAIT_V(2); PG8_BAR;
        PG8_STAGE(PG8_SB(1, 0), cB + kstep, voffB); PG8_STAGE(PG8_SA(1, 0), cA + kstep, voffA); PG8_STAGE(PG8_SB(1, 1), cB + hstep + kstep, voffB);
        PG8_WAIT_V(6); PG8_BAR;
    } else {
        PG8_STAGE(PG8_SB(0, 0), cB, voffB); PG8_STAGE(PG8_SA(0, 0), cA, voffA); PG8_STAGE(PG8_SB(0, 1), cB + hstep, voffB); PG8_STAGE(PG8_SA(0, 1), cA + hstep, voffA);
        if (wr == 1) PG8_BAR;
        PG8_WAIT_V(4); PG8_BAR;
        PG8_STAGE(PG8_SB(1, 0), cB + kstep, voffB); PG8_STAGE(PG8_SA(1, 0), cA + kstep, voffA); PG8_STAGE(PG8_SB(1, 1), cB + hstep + kstep, voffB);
        PG8_WAIT_V(6); PG8_BAR;
    }
    for (;;) {
        const bool has_next = S.next(ui + 1, nxt);
        const char* nA = has_next ? (const char*)g.A + (size_t)nxt.pm * tstep : cA; const char* nB = has_next ? (const char*)g.Bt + (size_t)nxt.pn * tstep : cB;
        for (int t = 0; t < nt; t += 2) {
            const bool last = (t == nt - 2);
            const char* a1 = cA + (size_t)(t + 1) * kstep;
            const char* a2 = last ? nA : cA + (size_t)(t + 2) * kstep; const char* b2 = last ? nB : cB + (size_t)(t + 2) * kstep;
            const char* a3 = a2 + kstep; const char* b3 = b2 + kstep;
            if (last && has_next) S.a_ready(nxt);
            if constexpr (SP2) {
            PG8_LDB(B0, 0, 0); PG8_LDB(B1, 0, 1); PG8_SCHED; PG8_LDA(At, 0, 0); PG8_STAGE(PG8_SA(1, 1), a1 + hstep, voffA);
            PG8_WAIT_V(8); PG8_WAIT_L(0); PG8_BAR; PG8_MMA(0, 0, At, B0); PG8_MMA(0, 1, At, B1); PG8_BAR; PG8_SCHED;
            PG8_LDA(At, 0, 1); PG8_STAGE(PG8_SB(0, 0), b2, voffB); PG8_STAGE(PG8_SB(0, 1), b2 + hstep, voffB); PG8_STAGE(PG8_SA(0, 0), a2, voffA);
            PG8_WAIT_V(8); PG8_WAIT_L(0); PG8_BAR; PG8_MMA(1, 0, At, B0); PG8_MMA(1, 1, At, B1); PG8_BAR; PG8_SCHED;
            PG8_LDB(B0, 1, 0); PG8_LDB(B1, 1, 1); PG8_SCHED; PG8_LDA(At, 1, 0); PG8_STAGE(PG8_SA(0, 1), a2 + hstep, voffA);
            PG8_WAIT_V(8); PG8_WAIT_L(0); PG8_BAR; PG8_MMA(0, 0, At, B0); PG8_MMA(0, 1, At, B1); PG8_BAR; PG8_SCHED;
            PG8_LDA(At, 1, 1); PG8_STAGE(PG8_SB(1, 0), b3, voffB); PG8_STAGE(PG8_SB(1, 1), b3 + hstep, voffB); PG8_STAGE(PG8_SA(1, 0), a3, voffA);
            PG8_WAIT_V(8); PG8_WAIT_L(0); PG8_BAR; PG8_MMA(1, 0, At, B0); PG8_MMA(1, 1, At, B1); PG8_BAR; PG8_SCHED;
            } else {
            PG8_LDB(B0, 0, 0); PG8_SCHED; PG8_LDA(At, 0, 0); PG8_STAGE(PG8_SA(1, 1), a1 + hstep, voffA);
            PG8_WAIT_L(8); PG8_BAR; PG8_WAIT_L(0); PG8_MMA(0, 0, At, B0); PG8_BAR; PG8_SCHED;
            PG8_LDB(B1, 0, 1); PG8_STAGE(PG8_SB(0, 0), b2, voffB);
            PG8_BAR; PG8_WAIT_L(0); PG8_MMA(0, 1, At, B1); PG8_BAR;
            PG8_LDA(At, 0, 1); PG8_STAGE(PG8_SA(0, 0), a2, voffA);
            PG8_BAR; PG8_WAIT_L(0); PG8_MMA(1, 0, At, B0); PG8_BAR; PG8_SCHED;
            PG8_STAGE(PG8_SB(0, 1), b2 + hstep, voffB);
            PG8_WAIT_V(6); PG8_BAR; PG8_MMA(1, 1, At, B1); PG8_BAR;
            PG8_LDB(B0, 1, 0); PG8_SCHED; PG8_LDA(At, 1, 0); PG8_STAGE(PG8_SA(0, 1), a2 + hstep, voffA);
            PG8_WAIT_L(8); PG8_BAR; PG8_WAIT_L(0); PG8_MMA(0, 0, At, B0); PG8_BAR; PG8_SCHED;
            PG8_LDB(B1, 1, 1); PG8_STAGE(PG8_SB(1, 0), b3, voffB);
            PG8_BAR; PG8_WAIT_L(0); PG8_MMA(0, 1, At, B1); PG8_BAR;
            PG8_LDA(At, 1, 1); PG8_STAGE(PG8_SA(1, 0), a3, voffA);
            PG8_BAR; PG8_WAIT_L(0); PG8_MMA(1, 0, At, B0); PG8_BAR; PG8_SCHED;
            PG8_STAGE(PG8_SB(1, 1), b3 + hstep, voffB);
            PG8_WAIT_V(6); PG8_BAR; PG8_MMA(1, 1, At, B1); PG8_BAR;
            }
        }
        if constexpr (ALIGN_EPI) { if (wr == 0) PG8_BAR; }
        if constexpr (!Epi::AFTER_DRAIN) { E(acc, cur, wr, wc, fr, fq); S.done(cur); }
        if (!has_next) break;
#pragma unroll
        for (int a = 0; a < 2; ++a)
#pragma unroll
            for (int b = 0; b < 2; ++b)
#pragma unroll
                for (int m = 0; m < 4; ++m)
#pragma unroll
                    for (int n = 0; n < 2; ++n) acc[a][b][m][n] = (f32x4){0.f, 0.f, 0.f, 0.f};
        cur = nxt; cA = nA; cB = nB; ++ui;
        if constexpr (ALIGN_EPI) { if (wr == 1) PG8_BAR; }
    }
    PG8_WAIT_V(0);
    if constexpr (!ALIGN_EPI) { if (wr == 0) PG8_BAR; }
    PG8_BAR;
    if constexpr (Epi::AFTER_DRAIN) { E.fused(acc, cur, wr, wc, fr, fq, lds, wid, lane); S.done(cur); }
#undef PG8_SA
#undef PG8_SB
#undef PG8_STAGE
#undef PG8_LDA
#undef PG8_LDB
#undef PG8_MMA
#undef PG8_WAIT_V
#undef PG8_WAIT_L
#undef PG8_BAR
#undef PG8_SCHED
}
}

#ifndef PG8_SP2
#define PG8_SP2 true
#endif
#ifndef PG8_ALIGN
#define PG8_ALIGN true
#endif
#include <hip/hip_bf16.h>
#include <cmath>
namespace attn_body {
using bf16=__hip_bfloat16;
using bf16x8=__attribute__((ext_vector_type(8)))short;
using s16x4=__attribute__((ext_vector_type(4)))short;
using f32x16=__attribute__((ext_vector_type(16)))float;
using u32x4=__attribute__((ext_vector_type(4)))unsigned;
constexpr int BATCH=2,NVH=32,SEQ=8192,D=64,PQ=1024,PO=2048;
constexpr int NW=8,QBLK=32,QB=QBLK*NW,KVBLK=64,NQB=SEQ/QB;
constexpr int ATTN_UNIT_ROWS=QB;
__device__ __forceinline__ int crow(int r,int hi){return (r&3)+8*(r>>2)+4*hi;}
#define SBAR() __builtin_amdgcn_sched_barrier(0)
__device__ __forceinline__ void cmask(f32x16&p0,f32x16&p1,int jb,int qrel,int hi){
  const float NEG=-INFINITY; int kb=64*jb+4*hi;
  #pragma unroll
  for(int r=0;r<16;++r){int kv=kb+(r&3)+8*(r>>2); if(kv>qrel)p0[r]=NEG; if(kv+32>qrel)p1[r]=NEG;}
}

constexpr int NSLOT=3, SLOTB=8192;
constexpr int LDS_K=0, LDS_V=NSLOT*SLOTB, LDS_WS=2*NSLOT*SLOTB, LDS_OST=LDS_WS+NW*64*4, LDS_BYTES=LDS_OST+NW*4096;
constexpr float C2=0.125f*1.4426950408889634f;
__device__ __forceinline__ void glds16(const void*gsrc,unsigned lds_dst){unsigned keep;
  asm volatile("s_mov_b32 %0, m0\n\ts_mov_b32 m0, %2\n\ts_nop 0\n\tglobal_load_lds_dwordx4 %1, off\n\ts_mov_b32 m0, %0":"=&s"(keep):"v"(gsrc),"s"(lds_dst):"memory");}
__device__ __forceinline__ float max3f(float a,float b,float c){float r;asm("v_max3_f32 %0, %1, %2, %3":"=v"(r):"v"(a),"v"(b),"v"(c));return r;}
__device__ __forceinline__ float max2f(float a,float b){float r;asm("v_max_f32_e32 %0, %1, %2":"=v"(r):"v"(a),"v"(b));return r;}
__device__ __forceinline__ float fadd_s(float a,float b){float r;asm("v_add_f32_e32 %0, %1, %2":"=v"(r):"v"(a),"v"(b));return r;}
__device__ __forceinline__ float fsub_s(float a,float b){float r;asm("v_sub_f32_e32 %0, %1, %2":"=v"(r):"v"(a),"v"(b));return r;}
typedef float f32x2_t __attribute__((ext_vector_type(2))); typedef __bf16 bf16x2_t __attribute__((ext_vector_type(2)));
__device__ __forceinline__ unsigned cvtpk_s(float lo,float hi){f32x2_t v={lo,hi};bf16x2_t b=__builtin_convertvector(v,bf16x2_t);return __builtin_bit_cast(unsigned,b);}
#define WAIT_BAR(N) asm volatile("s_waitcnt vmcnt(" #N ") lgkmcnt(0)\n\ts_barrier":::"memory")

__device__ __forceinline__ void qkt(f32x16&p0,f32x16&p1,const char*Kslot,const bf16x8*qr,const f32x16&negm,int r32,int hi){
  const char*kb=Kslot+hi*1024+r32*16;
  #pragma unroll
  for(int d0=0;d0<4;++d0){
    const bf16x8 b0=*reinterpret_cast<const bf16x8*>(kb+d0*2048);
    const bf16x8 b1=*reinterpret_cast<const bf16x8*>(kb+d0*2048+512);
    if(d0==0){p0=__builtin_amdgcn_mfma_f32_32x32x16_bf16(b0,qr[0],negm,0,0,0);p1=__builtin_amdgcn_mfma_f32_32x32x16_bf16(b1,qr[0],negm,0,0,0);}
    else{p0=__builtin_amdgcn_mfma_f32_32x32x16_bf16(b0,qr[d0],p0,0,0,0);p1=__builtin_amdgcn_mfma_f32_32x32x16_bf16(b1,qr[d0],p1,0,0,0);}}
}
typedef __attribute__((address_space(3))) const char* lds_cptr;
typedef short v4i16_t __attribute__((ext_vector_type(4)));
__device__ __forceinline__ void kload8(bf16x8*kf,lds_cptr kp){
  kf[0]=*(const __attribute__((address_space(3))) bf16x8*)(kp);      kf[1]=*(const __attribute__((address_space(3))) bf16x8*)(kp+512);
  kf[2]=*(const __attribute__((address_space(3))) bf16x8*)(kp+2048); kf[3]=*(const __attribute__((address_space(3))) bf16x8*)(kp+2560);
  kf[4]=*(const __attribute__((address_space(3))) bf16x8*)(kp+4096); kf[5]=*(const __attribute__((address_space(3))) bf16x8*)(kp+4608);
  kf[6]=*(const __attribute__((address_space(3))) bf16x8*)(kp+6144); kf[7]=*(const __attribute__((address_space(3))) bf16x8*)(kp+6656);
}
__device__ __forceinline__ void kload2(bf16x8*kf,lds_cptr kp,int j){ kf[2*j]=*(const __attribute__((address_space(3))) bf16x8*)(kp+j*2048); kf[2*j+1]=*(const __attribute__((address_space(3))) bf16x8*)(kp+j*2048+512); }
__device__ __forceinline__ s16x4 vtr(lds_cptr p){ return __builtin_bit_cast(s16x4,__builtin_amdgcn_ds_read_tr16_b64_v4i16((__attribute__((address_space(3))) v4i16_t*)p)); }
__device__ __forceinline__ float rowmax(const f32x16&p0,const f32x16&p1){
  float a=max3f(p0[0],p0[1],p1[0]),b=max3f(p0[2],p0[3],p1[1]);a=max3f(a,p1[2],p1[3]);
  #pragma unroll
  for(int r=4;r<16;r+=4){a=max3f(a,p0[r],p0[r+1]);b=max3f(b,p0[r+2],p0[r+3]);a=max3f(a,p1[r],p1[r+1]);b=max3f(b,p1[r+2],p1[r+3]);}
  const float m=max2f(a,b);
  auto rr=__builtin_amdgcn_permlane32_swap(__float_as_uint(m),__float_as_uint(m),false,false);
  return max2f(__uint_as_float(rr[0]),__uint_as_float(rr[1]));
}
__device__ __forceinline__ void pv(f32x16*o,int vb,bf16x8 pa0,bf16x8 pa1,bf16x8 pa2,bf16x8 pa3){
  #pragma unroll
  for(int d0=0;d0<2;++d0){s16x4 lo[4],hi[4];
    #pragma unroll
    for(int ks=0;ks<4;++ks){
      asm volatile("ds_read_b64_tr_b16 %0,%1 offset:%c2":"=&v"(lo[ks]):"v"(vb),"i"(d0*4096+ks*1024):"memory");
      asm volatile("ds_read_b64_tr_b16 %0,%1 offset:%c2":"=&v"(hi[ks]):"v"(vb),"i"(d0*4096+ks*1024+512):"memory");}
    asm volatile("s_waitcnt lgkmcnt(0)":::"memory");SBAR();
    #define PK(k) (bf16x8){lo[k][0],lo[k][1],lo[k][2],lo[k][3],hi[k][0],hi[k][1],hi[k][2],hi[k][3]}
    o[d0]=__builtin_amdgcn_mfma_f32_32x32x16_bf16(pa0,PK(0),o[d0],0,0,0);
    o[d0]=__builtin_amdgcn_mfma_f32_32x32x16_bf16(pa1,PK(1),o[d0],0,0,0);
    o[d0]=__builtin_amdgcn_mfma_f32_32x32x16_bf16(pa2,PK(2),o[d0],0,0,0);
    o[d0]=__builtin_amdgcn_mfma_f32_32x32x16_bf16(pa3,PK(3),o[d0],0,0,0);
    #undef PK
  }
}

#ifndef ATTN_STORE16
#define ATTN_STORE16(p,v) (*(u32x4*)(p)=(v))
#endif
template<int THRL,bool P2> __device__ __forceinline__ void attn_unit(int b,int qc,int kc,int vc,int oc,int qb,const bf16*Q,const bf16*__restrict__ K,const bf16*__restrict__ V,bf16*O,char*shm,float&mref,float&lref){
  int tid_=threadIdx.x; asm volatile("":"+v"(tid_));     const int tid=tid_,lane=tid&63,r32=lane&31,hi=lane>>5; const int wid=__builtin_amdgcn_readfirstlane(tid>>6);
  const long rowbase=(long)b*SEQ; const int q0=qb*QB;
  const bf16*Qw=Q+(rowbase+q0+wid*QBLK)*PQ+qc;
  const bf16*Kh=K+rowbase*PQ+kc,*Vh=V+rowbase*PQ+vc;
  const unsigned lds0=(unsigned)(uintptr_t)shm;
  float*wsf=(float*)(shm+LDS_WS)+wid*64;
  const bf16*ksrc=Kh+(long)lane*PQ+wid*8;
  const bf16*vsrc=Vh+(long)(16*(wid&3)+(lane>>2))*PQ+(wid>>2)*32+(lane&3)*8;
  const unsigned kdst=lds0+LDS_K+wid*1024, vdst=lds0+LDS_V+wid*1024;
  #define DMA_K(t,slot) glds16(ksrc+(long)(t)*KVBLK*PQ,(unsigned)__builtin_amdgcn_readfirstlane(kdst+(slot)))
  #define DMA_V(t,slot) glds16(vsrc+(long)(t)*KVBLK*PQ,(unsigned)__builtin_amdgcn_readfirstlane(vdst+(slot)))
  const int vb0=(int)(lds0+LDS_V)+((lane>>4)&1)*32+(lane&3)*8+(4*hi+((lane&15)>>2))*64;
  const char*Kbase=shm+LDS_K; bf16x8 kf[8];
  const lds_cptr shm3=(lds_cptr)shm; const lds_cptr kp0=shm3+LDS_K+hi*1024+r32*16; const lds_cptr vp0=shm3+LDS_V+((lane>>4)&1)*32+(lane&3)*8+(4*hi+((lane&15)>>2))*64;
  const int NT=(q0+QB)/KVBLK;
  DMA_K(0,0);DMA_V(0,0);DMA_K(1,SLOTB);
  bf16x8 qr[4];
  #pragma unroll
  for(int d0=0;d0<4;++d0)qr[d0]=*reinterpret_cast<const bf16x8*>(&Qw[(long)r32*PQ+d0*16+hi*8]);
  float mhat=0.f,l_reg=0.f;f32x16 o[2];o[0]=f32x16{};o[1]=f32x16{};f32x16 negm=f32x16{};asm volatile("":"+v"(negm));
  if(P2){ mhat=mref;
    _Pragma("unroll") for(int r=0;r<16;++r)negm[r]=-mhat; asm volatile("":"+v"(negm)); }
  const int qrel=wid*QBLK+r32;
  #define CMASK(P0,P1,t) do{int jb_=(t)-(NT-4); if(jb_>=0)cmask(P0,P1,jb_,qrel,hi);}while(0)
  bool resc=false;
  #define START(P0,P1) do{ resc=false; \
    if(!P2){ const float rm=rowmax(P0,P1); const float dl=rm; mhat=fadd_s(mhat,dl); \
      _Pragma("unroll") for(int r=0;r<16;++r){P0[r]=fsub_s(P0[r],dl);P1[r]=fsub_s(P1[r],dl);} \
      _Pragma("unroll") for(int r=0;r<16;++r)negm[r]=-mhat; asm volatile("":"+v"(negm)); } \
    _Pragma("unroll") for(int r=0;r<16;++r)P0[r]=__builtin_amdgcn_exp2f(P0[r]); }while(0)
  #define RESC() do{ if(resc){ asm volatile("s_waitcnt lgkmcnt(0)":::"memory"); \
      _Pragma("unroll") for(int d_=0;d_<2;++d_) _Pragma("unroll") for(int r=0;r<16;++r)o[d_][r]*=wsf[crow(r,hi)]; } }while(0)
  f32x16 pA0,pA1,pB0,pB1;
  int sl_prev=0,sl_cur=0,sl_next=SLOTB;
  #define ROT() do{sl_prev=sl_cur;sl_cur=sl_next;sl_next=(sl_next==(NSLOT-1)*SLOTB)?0:sl_next+SLOTB;}while(0)
  DMA_K(2,2*SLOTB);
  WAIT_BAR(3);
  qkt(pA0,pA1,Kbase,qr,negm,r32,hi);asm volatile("s_nop 15\n\ts_nop 7":"+v"(pA0),"+v"(pA1));CMASK(pA0,pA1,0);
  START(pA0,pA1);
  _Pragma("unroll") for(int r=0;r<16;++r)pA1[r]=__builtin_amdgcn_exp2f(pA1[r]);
  WAIT_BAR(0);
  DMA_K(3,0);DMA_V(1,SLOTB);
  ROT();
  kload8(kf,kp0+sl_cur);
  WAIT_BAR(2);
  s16x4 vlo[8],vhi[8]; u32x4 pw0,pw1,pw2,pw3;
  #define PKW(P,B) cvtpk_s(P[B],P[B+1])
  #define PAF(k) __builtin_bit_cast(bf16x8,pw##k)
  #define VFR(i) (bf16x8){vlo[i][0],vlo[i][1],vlo[i][2],vlo[i][3],vhi[i][0],vhi[i][1],vhi[i][2],vhi[i][3]}
  #define PIN(x) asm volatile("":"+v"(x))
  #define MX3(a,b,c) __builtin_fmaxf(__builtin_fmaxf((a),(b)),(c))
  #define GAPA(MF,A0,A1,A2,A3,W0,W1,PW) do{ MF; if(!P2){ sacc+=A0; sacc+=A1; sacc+=A2; sacc+=A3; PIN(sacc); } W0; W1; PIN(PW); SBAR(); }while(0)
  #define EX(v) __builtin_amdgcn_exp2f(v)
  #define GAPB(MF,X,B) do{ MF; X[B]=EX(X[B]); X[B+1]=EX(X[B+1]); X[B+2]=EX(X[B+2]); X[B+3]=EX(X[B+3]); PIN(X); SBAR(); }while(0)
  #define VRD(i) do{ vlo[i]=vtr(vp_+(((i)>>2)*4096+((i)&3)*1024)); vhi[i]=vtr(vp_+(((i)>>2)*4096+((i)&3)*1024+512)); }while(0)
  #define KRD(G,j) do{ if(G){ kload2(kf,kp0+sl_next,j); SBAR(); } }while(0)
  #define STEP(C0,C1,P0,P1,t,GK,GV,GL) do{ SBAR(); \
    const lds_cptr vp_=vp0+sl_prev; \
    VRD(0); SBAR(); float sacc=(P0[0]+P0[1]); \
    GAPA(C0=__builtin_amdgcn_mfma_f32_32x32x16_bf16(kf[0],qr[0],negm,0,0,0), P0[2],P0[3],P0[4],P0[5],     pw0[0]=PKW(P0,0), pw0[1]=PKW(P0,2), pw0); \
    VRD(4); SBAR(); GAPA(C1=__builtin_amdgcn_mfma_f32_32x32x16_bf16(kf[1],qr[0],negm,0,0,0), P0[6],P0[7],P0[8],P0[9],     pw0[2]=PKW(P0,4), pw0[3]=PKW(P0,6), pw0); \
    VRD(1); SBAR(); GAPA(C0=__builtin_amdgcn_mfma_f32_32x32x16_bf16(kf[2],qr[1],C0,0,0,0),   P0[10],P0[11],P0[12],P0[13], pw1[0]=PKW(P0,8), pw1[1]=PKW(P0,10), pw1); \
    VRD(5); SBAR(); GAPA(C1=__builtin_amdgcn_mfma_f32_32x32x16_bf16(kf[3],qr[1],C1,0,0,0),   P0[14],P0[15],P1[0],P1[1],   pw1[2]=PKW(P0,12),pw1[3]=PKW(P0,14), pw1); \
    VRD(2); SBAR(); GAPA(C0=__builtin_amdgcn_mfma_f32_32x32x16_bf16(kf[4],qr[2],C0,0,0,0),   P1[2],P1[3],P1[4],P1[5],     pw2[0]=PKW(P1,0), pw2[1]=PKW(P1,2), pw2); \
    VRD(6); SBAR(); GAPA(C1=__builtin_amdgcn_mfma_f32_32x32x16_bf16(kf[5],qr[2],C1,0,0,0),   P1[6],P1[7],P1[8],P1[9],     pw2[2]=PKW(P1,4), pw2[3]=PKW(P1,6), pw2); \
    VRD(3); SBAR(); GAPA(C0=__builtin_amdgcn_mfma_f32_32x32x16_bf16(kf[6],qr[3],C0,0,0,0),   P1[10],P1[11],P1[12],P1[13], pw3[0]=PKW(P1,8), pw3[1]=PKW(P1,10), pw3); \
    VRD(7); SBAR(); GAPA(C1=__builtin_amdgcn_mfma_f32_32x32x16_bf16(kf[7],qr[3],C1,0,0,0),   P1[14],P1[15],0.f,0.f,       pw3[2]=PKW(P1,12),pw3[3]=PKW(P1,14), pw3); \
    if(!P2)l_reg+=sacc; \
    if(GK){DMA_K((t)+3,sl_cur);} if(GV){DMA_V((t)+1,sl_next);} \
    CMASK(C0,C1,t); \
    if(!P2){ float a=MX3(C0[0],C0[1],C1[0]),b=MX3(C0[2],C0[3],C1[1]); a=MX3(a,C1[2],C1[3]); \
      _Pragma("unroll") for(int r=4;r<16;r+=4){a=MX3(a,C0[r],C0[r+1]);b=MX3(b,C0[r+2],C0[r+3]);a=MX3(a,C1[r],C1[r+1]);b=MX3(b,C1[r+2],C1[r+3]);} \
      float rm=__builtin_fmaxf(a,b); { auto rr=__builtin_amdgcn_permlane32_swap(__float_as_uint(rm),__float_as_uint(rm),false,false); rm=__builtin_fmaxf(__uint_as_float(rr[0]),__uint_as_float(rr[1])); } \
      resc=false; \
      if(__builtin_expect(__any(rm>(float)THRL),0)){ const float dl=__builtin_fmaxf(rm,0.f); mhat+=dl; \
        _Pragma("unroll") for(int r=0;r<16;++r){C0[r]-=dl;C1[r]-=dl;} \
        _Pragma("unroll") for(int r=0;r<16;++r)negm[r]=-mhat; asm volatile("":"+v"(negm)); \
        const float f=__builtin_amdgcn_exp2f(-dl); l_reg*=f; if(hi==0)wsf[r32]=f; resc=true; } } \
    SBAR(); \
    GAPB(o[0]=__builtin_amdgcn_mfma_f32_32x32x16_bf16(PAF(0),VFR(0),o[0],0,0,0), C0,0); \
    GAPB(o[1]=__builtin_amdgcn_mfma_f32_32x32x16_bf16(PAF(0),VFR(4),o[1],0,0,0), C0,4); \
    KRD(GL,0); GAPB(o[0]=__builtin_amdgcn_mfma_f32_32x32x16_bf16(PAF(1),VFR(1),o[0],0,0,0), C0,8); \
    KRD(GL,1); GAPB(o[1]=__builtin_amdgcn_mfma_f32_32x32x16_bf16(PAF(1),VFR(5),o[1],0,0,0), C0,12); \
    KRD(GL,2); GAPB(o[0]=__builtin_amdgcn_mfma_f32_32x32x16_bf16(PAF(2),VFR(2),o[0],0,0,0), C1,0); \
    KRD(GL,3); GAPB(o[1]=__builtin_amdgcn_mfma_f32_32x32x16_bf16(PAF(2),VFR(6),o[1],0,0,0), C1,4); \
    GAPB(o[0]=__builtin_amdgcn_mfma_f32_32x32x16_bf16(PAF(3),VFR(3),o[0],0,0,0), C1,8); \
    GAPB(o[1]=__builtin_amdgcn_mfma_f32_32x32x16_bf16(PAF(3),VFR(7),o[1],0,0,0), C1,12); \
    }while(0)
  int t=1;
  #undef CMASK
  #define CMASK(P0,P1,t) do{}while(0)
  for(;t+5<NT;t+=2){
    STEP(pB0,pB1,pA0,pA1,t,true,true,true);     WAIT_BAR(2); RESC(); ROT();
    STEP(pA0,pA1,pB0,pB1,t+1,true,true,true);   WAIT_BAR(2); RESC(); ROT();
  }
  #undef CMASK
  #define CMASK(P0,P1,t) do{int jb_=(t)-(NT-4); if(jb_>=0)cmask(P0,P1,jb_,qrel,hi);}while(0)
  #define ENDW(tt) do{ if((tt)+3<NT){WAIT_BAR(2);} else if((tt)+2<NT){WAIT_BAR(1);} else {WAIT_BAR(0);} }while(0)
  for(;t+1<NT;t+=2){
    STEP(pB0,pB1,pA0,pA1,t,(t+3<NT),(t+1<NT),(t+1<NT));       ENDW(t);   RESC(); ROT();
    STEP(pA0,pA1,pB0,pB1,t+1,(t+4<NT),(t+2<NT),(t+2<NT));     ENDW(t+1); RESC(); ROT();
  }
  STEP(pB0,pB1,pA0,pA1,NT-1,false,false,false); RESC();
  { float sacc=pB0[0]+pB0[1]; _Pragma("unroll") for(int r=2;r<16;++r)sacc+=pB0[r]; _Pragma("unroll") for(int r=0;r<16;++r)sacc+=pB1[r]; if(!P2)l_reg+=sacc;
    pw0=(u32x4){PKW(pB0,0),PKW(pB0,2),PKW(pB0,4),PKW(pB0,6)};pw1=(u32x4){PKW(pB0,8),PKW(pB0,10),PKW(pB0,12),PKW(pB0,14)};pw2=(u32x4){PKW(pB1,0),PKW(pB1,2),PKW(pB1,4),PKW(pB1,6)};pw3=(u32x4){PKW(pB1,8),PKW(pB1,10),PKW(pB1,12),PKW(pB1,14)};
    SBAR(); pv(o,vb0+sl_cur,PAF(0),PAF(1),PAF(2),PAF(3)); }
  #undef PKW
  #undef PAF
  #undef VFR
  #undef PIN
  #undef MX3
  #undef GAPA
  #undef GAPB
  #undef EX
  #undef VRD
  #undef KRD
  #undef STEP
  #undef ENDW
  if(!P2){auto rr=__builtin_amdgcn_permlane32_swap(__float_as_uint(l_reg),__float_as_uint(l_reg),false,false);l_reg=__uint_as_float(rr[0])+__uint_as_float(rr[1]); mref=mhat; lref=l_reg;}
  else l_reg=lref;
  if(hi==0)wsf[32+r32]=l_reg;asm volatile("s_waitcnt lgkmcnt(0)":::"memory");
  float rli[16];
  #pragma unroll
  for(int r=0;r<16;++r)rli[r]=__builtin_amdgcn_rcpf(wsf[32+crow(r,hi)]);
  bf16*Ow=O+(rowbase+q0+wid*QBLK)*PO+oc;
  { bf16*stg=(bf16*)(shm+LDS_OST)+wid*2048;
    #pragma unroll
    for(int r=0;r<16;++r){const int orow=crow(r,hi);
      #pragma unroll
      for(int d0=0;d0<2;++d0)stg[orow*64+d0*32+r32]=__float2bfloat16(o[d0][r]*rli[r]);}
    asm volatile("s_waitcnt lgkmcnt(0)":::"memory");
    #pragma unroll
    for(int i=0;i<4;++i){const int row=i*8+(lane>>3),ch=lane&7; const u32x4 v=*(const u32x4*)(stg+row*64+ch*8); ATTN_STORE16(Ow+(long)row*PO+ch*8,v);} }
  asm volatile("s_waitcnt lgkmcnt(0)\n\ts_barrier":::"memory");
  #undef DMA_K
  #undef DMA_V
  #undef CMASK
  #undef START
  #undef RESC
  #undef ROT
}
constexpr int ATTN_LDS_BYTES=LDS_BYTES;
struct AttnTensors { const bf16* Q; const bf16* K; const bf16* V; bf16* O; };
struct AttnUnit { int bh; int qb; };
struct StaticOrder {
  int vcu;
  __device__ __forceinline__ explicit StaticOrder(int grid,int block):vcu((grid%8==0)?(block%8)*(grid/8)+block/8:block),G(grid){}
  int G;
  __device__ __forceinline__ bool next(int i,AttnUnit&u)const{ const int n=i*G+vcu; if(n>=1024)return false; const int ii=n>>8,v=n&255,s=v&15; u.bh=(ii>>1)*16+(v>>4); u.qb=(ii&1)?31-s:s; return true;   const int k=0; u.qb=(k==0)?s:(k==1)?15-s:(k==2)?16+s:31-s; return true; }
  __device__ __forceinline__ void a_ready(const AttnUnit&)const{}
  __device__ __forceinline__ void done(const AttnUnit&)const{}
};
template<class Sched,int THRL=8> __device__ __forceinline__ void attn_phase(char*lds,const AttnTensors&T,const Sched&S){
  AttnUnit u;
  for(int i=0;S.next(i,u);++i){ S.a_ready(u); { const int bb=u.bh>>4,hc=u.bh&15; float mr_=0.f,lr_=0.f; attn_unit<THRL,false>(bb,hc*64,hc*64,(hc>>1)*128,(hc*2)*64,u.qb,T.Q,T.K,T.V,T.O,lds,mr_,lr_); int bb2=bb,hc2=hc,qb2=u.qb; asm volatile("":"+s"(bb2),"+s"(hc2),"+s"(qb2));     attn_unit<THRL,true>(bb2,hc2*64,hc2*64,(hc2>>1)*128+64,(hc2*2+1)*64,qb2,T.Q,T.K,T.V,T.O,lds,mr_,lr_); } S.done(u); }
}
#undef SBAR
#undef WAIT_BAR
}
#include <hip/hip_cooperative_groups.h>
namespace cg = cooperative_groups;
constexpr int NWAVES = 8;
#ifndef MK_N_LAUNCHES
#define MK_N_LAUNCHES 1
#endif
#ifndef MK_DUP
#define MK_DUP 0
#endif
#ifndef MK_YBF16
#define MK_YBF16 1
#endif
#ifndef MK_S5BF
#define MK_S5BF 1
#endif
#ifndef MK_XCCMAP
#define MK_XCCMAP 0
#endif
#ifndef MK_USE_CG
#define MK_USE_CG 0
#endif
constexpr int NPHASE = 15;
constexpr int BATCH = 2, T = 8192, D = 2048, FF = 5632, M = BATCH * T;
constexpr int AW = 1024, NG = 64, NP = 64, HC = 16, NCOND = 9 * D;
constexpr int CL = 32, NCH = T / CL;
constexpr float LN_EPS = 1e-5f, RMS_EPS = 1e-5f;
constexpr float DN_ALPHA = 1.18920711500272107f;
constexpr float LAMBDA_INIT = 0.2f;
constexpr size_t MiB = 1u << 20;
constexpr size_t WS_MOD = 1 * MiB, WS_LBR = 1 * MiB + 256 * 1024, WS_LBI = WS_LBR + 16384, WS_LCR = WS_LBI + 16384, WS_LCI = WS_LCR + 16384;
constexpr size_t WS_STATS = 3 * MiB, WS_Y3 = 402 * MiB;
constexpr size_t WS_BBR = 2 * MiB, WS_BBI = 2 * MiB + 256 * 1024;
constexpr size_t WS_W13A = 4 * MiB, WS_W2A = 48 * MiB, WS_W13B = 70 * MiB, WS_W2B = 114 * MiB, WS_WIN = 136 * MiB, WS_WOUT = 152 * MiB, WS_GLU = 160 * MiB;
constexpr size_t WS_U = 162 * MiB, WS_ACT = 226 * MiB;
constexpr size_t WS_Q = 226 * MiB, WS_K = 258 * MiB, WS_V = 290 * MiB, WS_S = 322 * MiB, WS_ST = 386 * MiB;
constexpr size_t WS_OATT = 402 * MiB, WS_CAT = 466 * MiB, WS_CARRY = 530 * MiB, WS_G = WS_Q, WS_END = 546 * MiB;
constexpr int RING_OFF = 0, RING_BYTES = 131072, MISC_OFF = RING_BYTES + 320, LDS_BYTES = 147456;
constexpr size_t CTL_ZERO_BYTES = 65536;

#define GAS __attribute__((address_space(1)))
#define LAS __attribute__((address_space(3)))
typedef unsigned short bf16;
typedef unsigned v4u __attribute__((ext_vector_type(4)));
typedef unsigned v2u __attribute__((ext_vector_type(2)));
typedef float f32x4 __attribute__((ext_vector_type(4)));
#define LDS_WAIT() asm volatile("s_waitcnt lgkmcnt(0)" ::: "memory")
__device__ __forceinline__ unsigned f2bf(float f) { unsigned u = __builtin_bit_cast(unsigned, f); return (u + 0x7fffu + ((u >> 16) & 1u)) >> 16; }
typedef float fr_f2 __attribute__((ext_vector_type(2))); typedef __bf16 fr_bf2 __attribute__((ext_vector_type(2)));
__device__ __forceinline__ unsigned pk2(float lo, float hi) { const fr_f2 v = {lo, hi}; return __builtin_bit_cast(unsigned, __builtin_convertvector(v, fr_bf2)); }
__device__ __forceinline__ float bflo(unsigned w) { return __uint_as_float(w << 16); }
__device__ __forceinline__ float bfhi(unsigned w) { return __uint_as_float(w & 0xffff0000u); }

struct Frame {
    LAS unsigned char* lds;
    int tid, lane, wave, vcu, G;
    float* out; unsigned char* ws;
};
__device__ __forceinline__ const float* inp(int i) {
    unsigned long long p;
    asm volatile("s_load_dwordx2 %0, %1, %2\n\ts_waitcnt lgkmcnt(0)" : "=s"(p) : "s"(__builtin_amdgcn_kernarg_segment_ptr()), "i"(8 * i));
    return (const float*)p;
}
__device__ __forceinline__ float wave_sum(float v) {
#pragma unroll
    for (int o = 1; o < 64; o <<= 1) v += __shfl_xor(v, o);
    return v;
}
__device__ __forceinline__ void p0_transpose_item(const float* W, int K, int N, bf16* WT, int k0, int n0, int drow0, LAS float* scr, int lane) {
#pragma unroll 8
    for (int i = 0; i < 32; ++i) { const int kk = 2 * i + (lane >> 5); scr[kk * 33 + (lane & 31)] = W[(size_t)(k0 + kk) * N + n0 + (lane & 31)]; }
    LDS_WAIT(); asm volatile("" ::: "memory");
    const int c = lane & 7;
#pragma unroll
    for (int j = 0; j < 4; ++j) { const int n = (lane >> 3) + 8 * j; const LAS float* s = scr + (8 * c) * 33 + n;
        v4u o; o.x = pk2(s[0 * 33], s[1 * 33]); o.y = pk2(s[2 * 33], s[3 * 33]); o.z = pk2(s[4 * 33], s[5 * 33]); o.w = pk2(s[6 * 33], s[7 * 33]);
        *(GAS v4u*)(WT + (size_t)(drow0 + n) * K + k0 + 8 * c) = o; }
    LDS_WAIT(); asm volatile("" ::: "memory");
}
__device__ __forceinline__ void p0_convert(Frame& F, const float* W, int K, int N, bf16* WT, int mode, int r) {
    LAS float* scr = (LAS float*)(F.lds + RING_OFF + F.wave * 16384);
    const int nblk = N / 32, kb = r / nblk, nb = r % nblk, n0 = 32 * nb;
    const int drow0 = mode == 0 ? n0 : (256 * (n0 >> 7) + (n0 & 127) + (mode == 2 ? 128 : 0));
    p0_transpose_item(W, K, N, WT, 64 * kb, n0, drow0, scr, F.lane);
}
struct CvtItem { const float* W; bf16* WT; int K, N, k0, drow0; };
#define CVT_CASE(cnt, inpidx, Kv, Nv, wsoff, mode) if (r < (cnt)) { constexpr int nblk = (Nv) / 32; const int kb = r / nblk, nb = r - kb * nblk, n0 = 32 * nb; \
    c.W = inp(inpidx) + (size_t)(64 * kb) * (Nv) + n0; c.WT = (bf16*)(F.ws + (wsoff)); c.K = (Kv); c.N = (Nv); c.k0 = 64 * kb; \
    c.drow0 = (mode) == 0 ? n0 : (256 * (n0 >> 7) + (n0 & 127) + ((mode) == 2 ? 128 : 0)); return true; } r -= (cnt);
__device__ __forceinline__ bool p0_decode(Frame& F, int it, CvtItem& c) {
    constexpr int I_F = (D / 64) * (FF / 32), I_IN = (D / 64) * (4096 / 32), I_OUT = (D / 64) * (D / 32), I_GLU = (1024 / 64) * (1024 / 32);
    constexpr int NITEMS = 6 * I_F + I_IN + I_OUT + I_GLU;
    if (it >= NITEMS) return false;
    int r = it;
    CVT_CASE(I_F, 4, D, FF, WS_W13A, 1)
    CVT_CASE(I_F, 5, D, FF, WS_W13A, 2)
    CVT_CASE(I_F, 6, FF, D, WS_W2A, 0)
    CVT_CASE(I_F, 24, D, FF, WS_W13B, 1)
    CVT_CASE(I_F, 25, D, FF, WS_W13B, 2)
    CVT_CASE(I_F, 26, FF, D, WS_W2B, 0)
    CVT_CASE(I_IN, 7, D, 4096, WS_WIN, 0)
    CVT_CASE(I_OUT, 23, D, D, WS_WOUT, 0)
    CVT_CASE(I_GLU, 21, 1024, 1024, WS_GLU, 0)
    return false;
}
__device__ __forceinline__ void p0_load(const CvtItem& c, int lane, float (&v)[32]) {
    const float* p = c.W + (size_t)(lane >> 5) * c.N + (lane & 31);
#pragma unroll
    for (int i = 0; i < 32; ++i) v[i] = p[(size_t)(2 * i) * c.N];
}
__device__ __forceinline__ void p0_store(const CvtItem& c, int lane, const float (&v)[32], LAS float* scr) {
#pragma unroll
    for (int i = 0; i < 32; ++i) scr[(2 * i + (lane >> 5)) * 33 + (lane & 31)] = v[i];
    LDS_WAIT(); asm volatile("" ::: "memory");
    const int ch = lane & 7;
#pragma unroll
    for (int j = 0; j < 4; ++j) { const int n = (lane >> 3) + 8 * j; const LAS float* s = scr + (8 * ch) * 33 + n;
        v4u o; o.x = pk2(s[0 * 33], s[1 * 33]); o.y = pk2(s[2 * 33], s[3 * 33]); o.z = pk2(s[4 * 33], s[5 * 33]); o.w = pk2(s[6 * 33], s[7 * 33]);
        *(GAS v4u*)(c.WT + (size_t)(c.drow0 + n) * c.K + c.k0 + 8 * ch) = o; }
    LDS_WAIT(); asm volatile("" ::: "memory");
}
__device__ __forceinline__ void sincos_d(double x, double& s, double& c) {
    const double TWO_PI = 6.283185307179586476925;
    const double k = __builtin_rint(x / TWO_PI);
    const double r = x - k * TWO_PI;
    const double y = r * 0.125, y2 = y * y;
    double sy = y * (1.0 + y2 * (-1.0 / 6.0 + y2 * (1.0 / 120.0 + y2 * (-1.0 / 5040.0 + y2 * (1.0 / 362880.0 + y2 * (-1.0 / 39916800.0 + y2 * (1.0 / 6227020800.0)))))));
    double cy = 1.0 + y2 * (-0.5 + y2 * (1.0 / 24.0 + y2 * (-1.0 / 720.0 + y2 * (1.0 / 40320.0 + y2 * (-1.0 / 3628800.0 + y2 * (1.0 / 479001600.0 + y2 * (-1.0 / 87178291200.0)))))));
#pragma unroll
    for (int i = 0; i < 3; ++i) { const double s2 = 2.0 * sy * cy, c2 = cy * cy - sy * sy; sy = s2; cy = c2; }
    s = sy; c = cy;
}
__device__ __forceinline__ double exp_d(double x) {
    const double LN2 = 0.693147180559945309417, k = __builtin_rint(x / LN2), r = (x - k * LN2) * 0.0625, r2 = r;
    double p = 1.0 + r2 * (1.0 + r2 * (0.5 + r2 * (1.0 / 6.0 + r2 * (1.0 / 24.0 + r2 * (1.0 / 120.0 + r2 * (1.0 / 720.0 + r2 * (1.0 / 5040.0 + r2 * (1.0 / 40320.0))))))));
#pragma unroll
    for (int i = 0; i < 4; ++i) p = p * p;
    return __builtin_ldexp(p, (int)k);
}
__device__ __forceinline__ void p0_prologue(Frame& F) {
    const float* c = inp(1); const float* w_cond = inp(2); const float* b_cond = inp(3);
    float* mod = (float*)(F.ws + WS_MOD);
    __syncthreads();
    {
        LAS float* sc = (LAS float*)(F.lds);
        LAS float* red = (LAS float*)(F.lds + 16384);
        for (int i = F.tid; i < 2 * D; i += NWAVES * 64) { const float a = c[i]; sc[i] = a * __builtin_amdgcn_rcpf(1.f + __builtin_amdgcn_exp2f(-1.44269504089f * a)); }
        __syncthreads();
        const int r = F.lane / 18, c4 = F.lane - 18 * r;
        for (int slab = blockIdx.x; slab < NCOND / 72; slab += F.G) {
            if (r < 3) {
                f32x4 a0 = (f32x4){0.f, 0.f, 0.f, 0.f}, a1 = (f32x4){0.f, 0.f, 0.f, 0.f};
                const int kb = F.wave * 256;
                const float* wp = w_cond + (size_t)(kb + r) * NCOND + slab * 72 + 4 * c4;
#pragma unroll 8
                for (int k = r; k < 256; k += 3) { const f32x4 w = *(const f32x4*)wp; wp += 3 * (size_t)NCOND; const float s0 = sc[kb + k], s1 = sc[D + kb + k]; a0 += w * s0; a1 += w * s1; }
                LAS f32x4* rp = (LAS f32x4*)(red + ((F.wave * 3 + r) * 2) * 72 + 4 * c4); rp[0] = a0; rp[18] = a1;
            }
            __syncthreads();
            if (F.tid < 144) { const int b = F.tid / 72, col = F.tid - 72 * b; float sum = 0.f;
#pragma unroll
                for (int p2 = 0; p2 < 24; ++p2) sum += red[(p2 * 2 + b) * 72 + col];
                mod[b * NCOND + slab * 72 + col] = sum + b_cond[slab * 72 + col]; }
            __syncthreads();
        }
    }
    {
        const int gt = F.vcu * (NWAVES * 64) + F.tid;
        if (gt < NG * NP) {
            const int g = gt >> 6;
            const double are = (double)inp(13)[gt], aim = (double)inp(14)[gt];
            const double dt = exp_d((double)inp(15)[g]);
            const double mag = exp_d(are * dt); double sn, cs; sincos_d(aim * dt, sn, cs);
            const double lr = mag * cs, li = mag * sn, nr = lr - 1.0, ni = li, den = are * are + aim * aim;
            const double cre = (nr * are + ni * aim) / den, cim = (ni * are - nr * aim) / den;
            ((float*)(F.ws + WS_LBR))[gt] = (float)lr; ((float*)(F.ws + WS_LBI))[gt] = (float)li;
            double pr = lr, pi = li;
#pragma unroll
            for (int i = 0; i < 5; ++i) { const double a = pr * pr - pi * pi, b = 2.0 * pr * pi; pr = a; pi = b; }
            ((float*)(F.ws + WS_LCR))[gt] = (float)pr; ((float*)(F.ws + WS_LCI))[gt] = (float)pi;
            const float* bre = inp(16) + (size_t)gt * HC; const float* bim = inp(17) + (size_t)gt * HC;
            float* obr = (float*)(F.ws + WS_BBR) + (size_t)gt * HC; float* obi = (float*)(F.ws + WS_BBI) + (size_t)gt * HC;
#pragma unroll
            for (int h = 0; h < HC; ++h) { const double br = bre[h], bi = bim[h]; obr[h] = (float)(cre * br - cim * bi); obi[h] = (float)(cre * bi + cim * br); }
        }
    }
    __syncthreads();
    {
        const int gw = F.vcu * NWAVES + F.wave, NGW = F.G * NWAVES;
        LAS float* scr = (LAS float*)(F.lds + RING_OFF + F.wave * 16384);
        CvtItem cur, nxt; float v[32], vn[32];
        bool has = p0_decode(F, gw, cur);
        if (has) p0_load(cur, F.lane, v);
        for (int it = gw; has; it += NGW) {
            const bool hn = p0_decode(F, it + NGW, nxt);
            if (hn) p0_load(nxt, F.lane, vn);
            p0_store(cur, F.lane, v, scr);
            cur = nxt; has = hn;
#pragma unroll
            for (int i = 0; i < 32; ++i) v[i] = vn[i];
        }
    }
}
__device__ __forceinline__ void modulate_phase(Frame& F, const float* X, const float* shift, const float* scale, bf16* U) {
    const int gw = F.vcu * NWAVES + F.wave, NGW = F.G * NWAVES;
    f32x4 sc1[8], sh[8], cur[8], nxt[8]; int cb = -1;
    if (gw < M) { const GAS f32x4* xr = (const GAS f32x4*)(X + (size_t)gw * D) + F.lane;
#pragma unroll
        for (int j = 0; j < 8; ++j) cur[j] = xr[64 * j]; }
    for (int m = gw; m < M; m += NGW) {
        const int b = m >> 13, mn = m + NGW;
        if (b != cb) { cb = b;
#pragma unroll
            for (int j = 0; j < 8; ++j) { const int col = 256 * j + 4 * F.lane; sc1[j] = *(const f32x4*)(scale + (size_t)b * NCOND + col) + 1.0f; sh[j] = *(const f32x4*)(shift + (size_t)b * NCOND + col); } }
        if (mn < M) { const GAS f32x4* xr = (const GAS f32x4*)(X + (size_t)mn * D) + F.lane;
#pragma unroll
            for (int j = 0; j < 8; ++j) nxt[j] = xr[64 * j]; }
        GAS v2u* ur = (GAS v2u*)(U + (size_t)m * D) + F.lane;
#pragma unroll
        for (int j = 0; j < 8; ++j) { const f32x4 o = cur[j] * sc1[j] + sh[j]; v2u w; w.x = pk2(o.x, o.y); w.y = pk2(o.z, o.w); ur[64 * j] = w; }
#pragma unroll
        for (int j = 0; j < 8; ++j) cur[j] = nxt[j];
    }
}
template <bool WRITE_U>
__device__ __forceinline__ void ln_phase(Frame& F, const float* Y, float* Xo, const float* lng, const float* lnb, const float* shift, const float* scale, bf16* U) {
    const int gw = F.vcu * NWAVES + F.wave, NGW = F.G * NWAVES;
    for (int m = gw; m < M; m += NGW) {
        const int b = m >> 13;
        const GAS f32x4* yr = (const GAS f32x4*)(Y + (size_t)m * D) + F.lane;
        f32x4 v[8]; float s = 0.f;
#pragma unroll
        for (int j = 0; j < 8; ++j) { v[j] = yr[64 * j]; s += (v[j].x + v[j].y) + (v[j].z + v[j].w); }
        const float mean = wave_sum(s) * (1.f / D); float s2 = 0.f;
#pragma unroll
        for (int j = 0; j < 8; ++j) { v[j] = v[j] - mean; s2 += (v[j].x * v[j].x + v[j].y * v[j].y) + (v[j].z * v[j].z + v[j].w * v[j].w); }
        const float rstd = 1.f / sqrtf(wave_sum(s2) * (1.f / D) + LN_EPS);
        GAS f32x4* xo = (GAS f32x4*)(Xo + (size_t)m * D) + F.lane;
        GAS v2u* ur = (GAS v2u*)(U + (size_t)m * D) + F.lane;
#pragma unroll
        for (int j = 0; j < 8; ++j) { const int col = 256 * j + 4 * F.lane;
            const f32x4 g4 = *(const f32x4*)(lng + col), b4 = *(const f32x4*)(lnb + col);
            const f32x4 o = v[j] * rstd * g4 + b4; xo[64 * j] = o;
            if (WRITE_U) { const f32x4 sc = *(const f32x4*)(scale + (size_t)b * NCOND + col), sh = *(const f32x4*)(shift + (size_t)b * NCOND + col);
                const f32x4 uu = o * (sc + 1.0f) + sh; v2u w; w.x = pk2(uu.x, uu.y); w.y = pk2(uu.z, uu.w); ur[64 * j] = w; } }
    }
}
template <bool FINAL, bool YBF>
__device__ __forceinline__ void ln_phase2(Frame& F, const void* Y, float* stats, float* Xo, const float* lng, const float* lnb, const float* shift, const float* scale, bf16* U) {
    constexpr int W = YBF ? 8 : 4, NJ = 32 / W, NR = YBF ? 4 : 8;
    const int gw = F.vcu * NWAVES + F.wave, NGW = F.G * NWAVES;
    f32x4 Gp[8], Bp[8]; int cb = -1;
    v4u cur[NR], nxt[NR];
    if (gw < M) {
#pragma unroll
        for (int j = 0; j < NR; ++j) cur[j] = YBF ? *(const GAS v4u*)((const bf16*)Y + (size_t)gw * D + 512 * j + 8 * F.lane) : *(const GAS v4u*)((const float*)Y + (size_t)gw * D + 256 * j + 4 * F.lane); }
    for (int m = gw; m < M; m += NGW) {
        const int b = m >> 13, mn = m + NGW;
        if ((FINAL && cb < 0) || (!FINAL && b != cb)) { cb = b;
#pragma unroll
            for (int j = 0; j < NJ; ++j)
#pragma unroll
                for (int q = 0; q < W / 4; ++q) { const int col = 64 * W * j + W * F.lane + 4 * q, jq = j * (W / 4) + q;
                    const f32x4 g4 = *(const f32x4*)(lng + col), b4 = *(const f32x4*)(lnb + col);
                    if (FINAL) { Gp[jq] = g4; Bp[jq] = b4; }
                    else { const f32x4 s1 = *(const f32x4*)(scale + (size_t)b * NCOND + col) + 1.0f, sh = *(const f32x4*)(shift + (size_t)b * NCOND + col); Gp[jq] = g4 * s1; Bp[jq] = b4 * s1 + sh; } } }
        if (mn < M) {
#pragma unroll
            for (int j = 0; j < NR; ++j) nxt[j] = YBF ? *(const GAS v4u*)((const bf16*)Y + (size_t)mn * D + 512 * j + 8 * F.lane) : *(const GAS v4u*)((const float*)Y + (size_t)mn * D + 256 * j + 4 * F.lane); }
        float v[32]; float s = 0.f;
#pragma unroll
        for (int j = 0; j < NR; ++j) { const v4u w = cur[j];
            if (YBF) { v[8 * j + 0] = bflo(w.x); v[8 * j + 1] = bfhi(w.x); v[8 * j + 2] = bflo(w.y); v[8 * j + 3] = bfhi(w.y); v[8 * j + 4] = bflo(w.z); v[8 * j + 5] = bfhi(w.z); v[8 * j + 6] = bflo(w.w); v[8 * j + 7] = bfhi(w.w); }
            else { v[4 * j + 0] = __uint_as_float(w.x); v[4 * j + 1] = __uint_as_float(w.y); v[4 * j + 2] = __uint_as_float(w.z); v[4 * j + 3] = __uint_as_float(w.w); } }
#pragma unroll
        for (int i = 0; i < 32; i += 4) s += (v[i] + v[i + 1]) + (v[i + 2] + v[i + 3]);
        const float mean = wave_sum(s) * (1.f / D); float s2 = 0.f;
#pragma unroll
        for (int i = 0; i < 32; ++i) { v[i] -= mean; s2 += v[i] * v[i]; }
        const float rstd = 1.f / sqrtf(wave_sum(s2) * (1.f / D) + LN_EPS);
        if (!FINAL && F.lane == 0) { stats[2 * (size_t)m] = mean; stats[2 * (size_t)m + 1] = rstd; }
#pragma unroll
        for (int j = 0; j < NJ; ++j) { const int col = 64 * W * j + W * F.lane;
            float o[W];
#pragma unroll
            for (int q = 0; q < W / 4; ++q) { const int jq = j * (W / 4) + q;
#pragma unroll
                for (int i = 0; i < 4; ++i) o[4 * q + i] = v[W * j + 4 * q + i] * rstd * Gp[jq][i] + Bp[jq][i]; }
            if (FINAL) {
#pragma unroll
                for (int q = 0; q < W / 4; ++q) *(GAS f32x4*)(Xo + (size_t)m * D + col + 4 * q) = (f32x4){o[4 * q], o[4 * q + 1], o[4 * q + 2], o[4 * q + 3]};
            } else {
                if (YBF) { v4u w; w.x = pk2(o[0], o[1]); w.y = pk2(o[2], o[3]); w.z = pk2(o[W - 4], o[W - 3]); w.w = pk2(o[W - 2], o[W - 1]); *(GAS v4u*)(U + (size_t)m * D + col) = w; }
                else { v2u w; w.x = pk2(o[0], o[1]); w.y = pk2(o[2], o[3]); *(GAS v2u*)(U + (size_t)m * D + col) = w; }
            } }
#pragma unroll
        for (int j = 0; j < NR; ++j) cur[j] = nxt[j];
    }
}
template <bool FINAL, bool YBF>
__device__ __forceinline__ void ln_phase3(Frame& F, const void* Y, float* stats, float* Xo, const float* lng, const float* lnb, const float* shift, const float* scale, bf16* U) {
    constexpr int W = YBF ? 8 : 4, NJ = 32 / W, NR = YBF ? 4 : 8;
    const int gw = F.vcu * NWAVES + F.wave, NGW = F.G * NWAVES;
    LAS f32x4* tG = (LAS f32x4*)(F.lds); LAS f32x4* tB = tG + 1024;
    { const int col = 4 * F.tid; const f32x4 g4 = *(const f32x4*)(lng + col), b4 = *(const f32x4*)(lnb + col);
#pragma unroll
      for (int b = 0; b < 2; ++b) {
          if (FINAL) { tG[b * 512 + F.tid] = g4; tB[b * 512 + F.tid] = b4; }
          else { const f32x4 s1 = *(const f32x4*)(scale + (size_t)b * NCOND + col) + 1.0f, sh = *(const f32x4*)(shift + (size_t)b * NCOND + col); tG[b * 512 + F.tid] = g4 * s1; tB[b * 512 + F.tid] = b4 * s1 + sh; } } }
    __syncthreads();
#define LN3_LOAD(dst, mm) do { _Pragma("unroll") for (int j = 0; j < NR; ++j) dst[j] = YBF ? *(const GAS v4u*)((const bf16*)Y + (size_t)(mm) * D + 512 * j + 8 * F.lane) : *(const GAS v4u*)((const float*)Y + (size_t)(mm) * D + 256 * j + 4 * F.lane); } while (0)
    v4u cur[NR], nx1[NR], nxt[NR];
    if (gw < M) LN3_LOAD(cur, gw);
    if (gw + NGW < M) LN3_LOAD(nx1, gw + NGW);
    for (int m = gw; m < M; m += NGW) {
        const int b = m >> 13, mn = m + 2 * NGW;
        if (mn < M) LN3_LOAD(nxt, mn);
        float v[32]; float s = 0.f;
#pragma unroll
        for (int j = 0; j < NR; ++j) { const v4u w = cur[j];
            if (YBF) { v[8 * j + 0] = bflo(w.x); v[8 * j + 1] = bfhi(w.x); v[8 * j + 2] = bflo(w.y); v[8 * j + 3] = bfhi(w.y); v[8 * j + 4] = bflo(w.z); v[8 * j + 5] = bfhi(w.z); v[8 * j + 6] = bflo(w.w); v[8 * j + 7] = bfhi(w.w); }
            else { v[4 * j + 0] = __uint_as_float(w.x); v[4 * j + 1] = __uint_as_float(w.y); v[4 * j + 2] = __uint_as_float(w.z); v[4 * j + 3] = __uint_as_float(w.w); } }
#pragma unroll
        for (int i = 0; i < 32; i += 4) s += (v[i] + v[i + 1]) + (v[i + 2] + v[i + 3]);
        const float mean = wave_sum(s) * (1.f / D); float s2 = 0.f;
#pragma unroll
        for (int i = 0; i < 32; ++i) { v[i] -= mean; s2 += v[i] * v[i]; }
        const float rstd = 1.f / sqrtf(wave_sum(s2) * (1.f / D) + LN_EPS);
        if (!FINAL && F.lane == 0) { stats[2 * (size_t)m] = mean; stats[2 * (size_t)m + 1] = rstd; }
#pragma unroll
        for (int j = 0; j < NJ; ++j) { const int col = 64 * W * j + W * F.lane;
            float o[W];
#pragma unroll
            for (int q = 0; q < W / 4; ++q) { const f32x4 G4 = tG[b * 512 + (col >> 2) + q], B4 = tB[b * 512 + (col >> 2) + q];
#pragma unroll
                for (int i = 0; i < 4; ++i) o[4 * q + i] = v[W * j + 4 * q + i] * rstd * G4[i] + B4[i]; }
            if (FINAL) {
#pragma unroll
                for (int q = 0; q < W / 4; ++q) *(GAS f32x4*)(Xo + (size_t)m * D + col + 4 * q) = (f32x4){o[4 * q], o[4 * q + 1], o[4 * q + 2], o[4 * q + 3]};
            } else {
                if (YBF) { v4u w; w.x = pk2(o[0], o[1]); w.y = pk2(o[2], o[3]); w.z = pk2(o[W - 4], o[W - 3]); w.w = pk2(o[W - 2], o[W - 1]); *(GAS v4u*)(U + (size_t)m * D + col) = w; }
                else { v2u w; w.x = pk2(o[0], o[1]); w.y = pk2(o[2], o[3]); *(GAS v2u*)(U + (size_t)m * D + col) = w; }
            } }
#pragma unroll
        for (int j = 0; j < NR; ++j) { cur[j] = nx1[j]; nx1[j] = nxt[j]; }
    }
#undef LN3_LOAD
    __syncthreads();
}
typedef float s5x4 __attribute__((ext_vector_type(4)));
template <bool OUT>
__device__ __forceinline__ void s5_scan(Frame& F) {
    const int lane = F.lane, j = lane & 15, q = lane >> 4;
    const int gw = F.vcu * NWAVES + F.wave, NGW = F.G * NWAVES;
    const float* BBR = (const float*)(F.ws + WS_BBR); const float* BBI = (const float*)(F.ws + WS_BBI);
    const float* LBR = (const float*)(F.ws + WS_LBR); const float* LBI = (const float*)(F.ws + WS_LBI);
    const float* S = (const float*)(F.ws + WS_S);
    for (int it = gw; it < BATCH * NG * (NCH / 16); it += NGW) {
        const int bg = it >> 4, w = it & 15, b = bg >> 6, g = bg & 63;
        s5x4 ainr[4], aini[4], lr[4], li[4], aoutr[4], aouti[4], hr[4], hi[4];
#pragma unroll
        for (int sb = 0; sb < 4; ++sb) {
            ainr[sb] = *(const s5x4*)(BBR + (size_t)(g * 64 + 16 * sb + j) * HC + 4 * q);
            aini[sb] = *(const s5x4*)(BBI + (size_t)(g * 64 + 16 * sb + j) * HC + 4 * q);
            lr[sb] = *(const s5x4*)(LBR + g * 64 + 16 * sb + 4 * q); li[sb] = *(const s5x4*)(LBI + g * 64 + 16 * sb + 4 * q);
            if (OUT) { aoutr[sb] = *(const s5x4*)(inp(18) + (size_t)(g * 16 + j) * NP + 16 * sb + 4 * q);
                       aouti[sb] = -*(const s5x4*)(inp(19) + (size_t)(g * 16 + j) * NP + 16 * sb + 4 * q); }
        }
        const int ch = 16 * w + j;
        const size_t stoff = ((size_t)(bg * NCH + ch) * 2) * NP + 4 * q;
        if (OUT) { const float* CY = (const float*)(F.ws + WS_CARRY) + stoff;
#pragma unroll
            for (int sb = 0; sb < 4; ++sb) { hr[sb] = *(const s5x4*)(CY + 16 * sb); hi[sb] = *(const s5x4*)(CY + NP + 16 * sb); } }
        else {
#pragma unroll
            for (int sb = 0; sb < 4; ++sb) { hr[sb] = (s5x4){0.f, 0.f, 0.f, 0.f}; hi[sb] = (s5x4){0.f, 0.f, 0.f, 0.f}; } }
        const size_t row0 = (size_t)b * T + (size_t)ch * CL;
        const float* sp = S + row0 * 1024 + g * 16 + 4 * q;
        s5x4 dsk = (s5x4){0.f, 0.f, 0.f, 0.f}; if (OUT) dsk = *(const s5x4*)(inp(20) + g * 16 + 4 * q);
        bf16* gp = (bf16*)(F.ws + WS_G) + row0 * 1024 + g * 16 + 4 * q;
        s5x4 uv = *(const s5x4*)sp;
        for (int t = 0; t < CL; ++t) {
            const s5x4 un = *(const s5x4*)(sp + (size_t)(t + 1 < CL ? t + 1 : t) * 1024);
            s5x4 tr[4], ti[4];
#pragma unroll
            for (int sb = 0; sb < 4; ++sb) { tr[sb] = lr[sb] * hr[sb] - li[sb] * hi[sb]; ti[sb] = lr[sb] * hi[sb] + li[sb] * hr[sb]; }
#pragma unroll
            for (int kk = 0; kk < 4; ++kk)
#pragma unroll
                for (int sb = 0; sb < 4; ++sb) { tr[sb] = __builtin_amdgcn_mfma_f32_16x16x4f32(ainr[sb][kk], uv[kk], tr[sb], 0, 0, 0);
                                                 ti[sb] = __builtin_amdgcn_mfma_f32_16x16x4f32(aini[sb][kk], uv[kk], ti[sb], 0, 0, 0); }
#pragma unroll
            for (int sb = 0; sb < 4; ++sb) { hr[sb] = tr[sb]; hi[sb] = ti[sb]; }
            if (OUT) {
                s5x4 y0 = dsk * uv, y1 = (s5x4){0.f, 0.f, 0.f, 0.f};
#pragma unroll
                for (int sb = 0; sb < 4; ++sb)
#pragma unroll
                    for (int r = 0; r < 4; ++r) { y0 = __builtin_amdgcn_mfma_f32_16x16x4f32(aoutr[sb][r], hr[sb][r], y0, 0, 0, 0);
                                                  y1 = __builtin_amdgcn_mfma_f32_16x16x4f32(aouti[sb][r], hi[sb][r], y1, 0, 0, 0); }
                const s5x4 y = y0 + y1; float o[4];
#pragma unroll
                for (int i = 0; i < 4; ++i) { const float v = y[i], z = 1.5957691216f * (v + 0.044715f * v * v * v);
                    o[i] = v * __builtin_amdgcn_rcpf(1.f + __builtin_amdgcn_exp2f(-1.44269504089f * z)); }
                v2u wv; wv.x = pk2(o[0], o[1]); wv.y = pk2(o[2], o[3]);
                *(GAS v2u*)(gp + (size_t)t * 1024) = wv;
            }
            uv = un;
        }
        if (!OUT) { float* ST = (float*)(F.ws + WS_ST) + stoff;
#pragma unroll
            for (int sb = 0; sb < 4; ++sb) { *(s5x4*)(ST + 16 * sb) = hr[sb]; *(s5x4*)(ST + NP + 16 * sb) = hi[sb]; } }
    }
}
typedef short s5h8 __attribute__((ext_vector_type(8)));
__device__ __forceinline__ s5h8 s5_pack8(s5x4 a, s5x4 b) { v4u w; w.x = pk2(a[0], a[1]); w.y = pk2(a[2], a[3]); w.z = pk2(b[0], b[1]); w.w = pk2(b[2], b[3]); return __builtin_bit_cast(s5h8, w); }
template <bool OUT>
__device__ __forceinline__ void s5_scan_bf(Frame& F) {
    const int lane = F.lane, j = lane & 15, q = lane >> 4, qc = 8 * (q & 1);
    const bool lopart = q >= 2;
    const int gw = F.vcu * NWAVES + F.wave, NGW = F.G * NWAVES;
    const float* BBR = (const float*)(F.ws + WS_BBR); const float* BBI = (const float*)(F.ws + WS_BBI);
    const float* LBR = (const float*)(F.ws + WS_LBR); const float* LBI = (const float*)(F.ws + WS_LBI);
    const float* S = (const float*)(F.ws + WS_S);
    for (int it = gw; it < BATCH * NG * (NCH / 16); it += NGW) {
        const int bg = it >> 4, w = it & 15, b = bg >> 6, g = bg & 63;
        s5h8 ainr[4], aini[4], aoutr[2], aouti[2]; s5x4 lr[4], li[4], hr[4], hi[4];
#pragma unroll
        for (int sb = 0; sb < 4; ++sb) {
            const float* pr = BBR + (size_t)(g * 64 + 16 * sb + j) * HC + qc; const float* pi = BBI + (size_t)(g * 64 + 16 * sb + j) * HC + qc;
            ainr[sb] = s5_pack8(*(const s5x4*)pr, *(const s5x4*)(pr + 4)); aini[sb] = s5_pack8(*(const s5x4*)pi, *(const s5x4*)(pi + 4));
            lr[sb] = *(const s5x4*)(LBR + g * 64 + 16 * sb + 4 * q); li[sb] = *(const s5x4*)(LBI + g * 64 + 16 * sb + 4 * q);
        }
        if (OUT) {
#pragma unroll
            for (int sp = 0; sp < 2; ++sp) {
                const float* cr = inp(18) + (size_t)(g * 16 + j) * NP + 32 * sp + 4 * q; const float* ci = inp(19) + (size_t)(g * 16 + j) * NP + 32 * sp + 4 * q;
                aoutr[sp] = s5_pack8(*(const s5x4*)cr, *(const s5x4*)(cr + 16)); aouti[sp] = s5_pack8(-*(const s5x4*)ci, -*(const s5x4*)(ci + 16));
            }
        }
        const int ch = 16 * w + j;
        const size_t stoff = ((size_t)(bg * NCH + ch) * 2) * NP + 4 * q;
        if (OUT) { const float* CY = (const float*)(F.ws + WS_CARRY) + stoff;
#pragma unroll
            for (int sb = 0; sb < 4; ++sb) { hr[sb] = *(const s5x4*)(CY + 16 * sb); hi[sb] = *(const s5x4*)(CY + NP + 16 * sb); } }
        else {
#pragma unroll
            for (int sb = 0; sb < 4; ++sb) { hr[sb] = (s5x4){0.f, 0.f, 0.f, 0.f}; hi[sb] = (s5x4){0.f, 0.f, 0.f, 0.f}; } }
        const size_t row0 = (size_t)b * T + (size_t)ch * CL;
        const float* sp8 = S + row0 * 1024 + g * 16 + qc;
        const float* sp4 = S + row0 * 1024 + g * 16 + 4 * q;
        s5x4 dsk = (s5x4){0.f, 0.f, 0.f, 0.f}; if (OUT) dsk = *(const s5x4*)(inp(20) + g * 16 + 4 * q);
        bf16* gp = (bf16*)(F.ws + WS_G) + row0 * 1024 + g * 16 + 4 * q;
        s5x4 ua = *(const s5x4*)sp8, ub = *(const s5x4*)(sp8 + 4), u4 = (s5x4){0.f, 0.f, 0.f, 0.f}; if (OUT) u4 = *(const s5x4*)sp4;
        for (int t = 0; t < CL; ++t) {
            const size_t tn = (size_t)(t + 1 < CL ? t + 1 : t) * 1024;
            const s5x4 na = *(const s5x4*)(sp8 + tn), nb = *(const s5x4*)(sp8 + tn + 4); s5x4 n4 = u4; if (OUT) n4 = *(const s5x4*)(sp4 + tn);
            s5h8 ufrag;
            { const s5h8 uh = s5_pack8(ua, ub); const v4u hw = __builtin_bit_cast(v4u, uh);
              s5x4 ra, rb;
              ra[0] = ua[0] - bflo(hw.x); ra[1] = ua[1] - bfhi(hw.x); ra[2] = ua[2] - bflo(hw.y); ra[3] = ua[3] - bfhi(hw.y);
              rb[0] = ub[0] - bflo(hw.z); rb[1] = ub[1] - bfhi(hw.z); rb[2] = ub[2] - bflo(hw.w); rb[3] = ub[3] - bfhi(hw.w);
              const s5h8 ul = s5_pack8(ra, rb); ufrag = lopart ? ul : uh; }
            s5x4 tr[4], ti[4];
#pragma unroll
            for (int sb = 0; sb < 4; ++sb) { tr[sb] = lr[sb] * hr[sb] - li[sb] * hi[sb]; ti[sb] = lr[sb] * hi[sb] + li[sb] * hr[sb]; }
#pragma unroll
            for (int sb = 0; sb < 4; ++sb) { hr[sb] = __builtin_amdgcn_mfma_f32_16x16x32_bf16(ainr[sb], ufrag, tr[sb], 0, 0, 0);
                                             hi[sb] = __builtin_amdgcn_mfma_f32_16x16x32_bf16(aini[sb], ufrag, ti[sb], 0, 0, 0); }
            if (OUT) {
                s5x4 y0 = dsk * u4, y1 = (s5x4){0.f, 0.f, 0.f, 0.f};
#pragma unroll
                for (int sp = 0; sp < 2; ++sp) { y0 = __builtin_amdgcn_mfma_f32_16x16x32_bf16(aoutr[sp], s5_pack8(hr[2 * sp], hr[2 * sp + 1]), y0, 0, 0, 0);
                                                 y1 = __builtin_amdgcn_mfma_f32_16x16x32_bf16(aouti[sp], s5_pack8(hi[2 * sp], hi[2 * sp + 1]), y1, 0, 0, 0); }
                const s5x4 y = y0 + y1; float o[4];
#pragma unroll
                for (int i = 0; i < 4; ++i) { const float v = y[i], z = 1.5957691216f * (v + 0.044715f * v * v * v);
                    o[i] = v * __builtin_amdgcn_rcpf(1.f + __builtin_amdgcn_exp2f(-1.44269504089f * z)); }
                v2u wv; wv.x = pk2(o[0], o[1]); wv.y = pk2(o[2], o[3]);
                *(GAS v2u*)(gp + (size_t)t * 1024) = wv;
            }
            ua = na; ub = nb; u4 = n4;
        }
        if (!OUT) { float* ST = (float*)(F.ws + WS_ST) + stoff;
#pragma unroll
            for (int sb = 0; sb < 4; ++sb) { *(s5x4*)(ST + 16 * sb) = hr[sb]; *(s5x4*)(ST + NP + 16 * sb) = hi[sb]; } }
    }
}
__device__ __forceinline__ void s5_carry(Frame& F) {
    LAS float* tot = (LAS float*)(F.lds);
    for (int bg = F.vcu; bg < BATCH * NG; bg += F.G) {
        const int g = bg & 63, p = F.lane, w = F.wave;
        const float Lr = ((const float*)(F.ws + WS_LCR))[g * 64 + p], Li = ((const float*)(F.ws + WS_LCI))[g * 64 + p];
        const float* __restrict__ ST = (const float*)(F.ws + WS_ST) + ((size_t)bg * NCH + 32 * w) * 2 * NP + p;
        float* __restrict__ CY = (float*)(F.ws + WS_CARRY) + ((size_t)bg * NCH + 32 * w) * 2 * NP + p;
        float sr[32], si[32];
#pragma unroll
        for (int c = 0; c < 32; ++c) { sr[c] = ST[(size_t)c * 2 * NP]; si[c] = ST[(size_t)c * 2 * NP + NP]; }
        float cr = 0.f, ci = 0.f;
#pragma unroll
        for (int c = 0; c < 32; ++c) { const float tr = sr[c], ti = si[c]; sr[c] = cr; si[c] = ci; const float nr = Lr * cr - Li * ci + tr, ni = Lr * ci + Li * cr + ti; cr = nr; ci = ni; }
        tot[(w * 2 + 0) * 64 + p] = cr; tot[(w * 2 + 1) * 64 + p] = ci;
        __syncthreads();
        float Pr = Lr, Pi = Li;
#pragma unroll
        for (int i = 0; i < 5; ++i) { const float a = Pr * Pr - Pi * Pi, b2 = 2.f * Pr * Pi; Pr = a; Pi = b2; }
        float ar = 0.f, ai = 0.f;
        for (int v = 0; v < w; ++v) { const float tr = tot[(v * 2 + 0) * 64 + p], ti = tot[(v * 2 + 1) * 64 + p]; const float nr = Pr * ar - Pi * ai + tr, ni = Pr * ai + Pi * ar + ti; ar = nr; ai = ni; }
        float qr = 1.f, qi = 0.f;
#pragma unroll
        for (int c = 0; c < 32; ++c) { CY[(size_t)c * 2 * NP] = sr[c] + qr * ar - qi * ai; CY[(size_t)c * 2 * NP + NP] = si[c] + qr * ai + qi * ar;
            const float nr = qr * Lr - qi * Li, ni = qr * Li + qi * Lr; qr = nr; qi = ni; }
        __syncthreads();
    }
}
__device__ __forceinline__ void attn_combine(Frame& F) {
    const int gw = F.vcu * NWAVES + F.wave, NGW = F.G * NWAVES;
    float d1 = 0.f, d2 = 0.f;
    { const float a = inp(8)[F.lane] * inp(9)[F.lane], b = inp(10)[F.lane] * inp(11)[F.lane]; d1 = wave_sum(a); d2 = wave_sum(b); }
    const float lam = __expf(d1) - __expf(d2) + LAMBDA_INIT;
    const int h = F.lane >> 3, e0 = (F.lane & 7) * 16;
    float gsub[16];
#pragma unroll
    for (int i = 0; i < 16; ++i) gsub[i] = inp(12)[e0 + i] * (1.0f - LAMBDA_INIT);
    const bf16* OA = (const bf16*)(F.ws + WS_OATT); bf16* CAT = (bf16*)(F.ws + WS_CAT);
    v4u a0, a1, b0, b1, na0, na1, nb0, nb1;
    if (gw < M) { const GAS v4u* p0 = (const GAS v4u*)(OA + (size_t)gw * 2048 + (h * 2 + 0) * 128 + e0); const GAS v4u* p1 = (const GAS v4u*)(OA + (size_t)gw * 2048 + (h * 2 + 1) * 128 + e0);
        a0 = p0[0]; a1 = p0[1]; b0 = p1[0]; b1 = p1[1]; }
    for (int m = gw; m < M; m += NGW) {
        const int mn = m + NGW;
        if (mn < M) { const GAS v4u* p0 = (const GAS v4u*)(OA + (size_t)mn * 2048 + (h * 2 + 0) * 128 + e0); const GAS v4u* p1 = (const GAS v4u*)(OA + (size_t)mn * 2048 + (h * 2 + 1) * 128 + e0);
            na0 = p0[0]; na1 = p0[1]; nb0 = p1[0]; nb1 = p1[1]; }
        float o[16];
        o[0] = bflo(a0.x) - lam * bflo(b0.x); o[1] = bfhi(a0.x) - lam * bfhi(b0.x); o[2] = bflo(a0.y) - lam * bflo(b0.y); o[3] = bfhi(a0.y) - lam * bfhi(b0.y);
        o[4] = bflo(a0.z) - lam * bflo(b0.z); o[5] = bfhi(a0.z) - lam * bfhi(b0.z); o[6] = bflo(a0.w) - lam * bflo(b0.w); o[7] = bfhi(a0.w) - lam * bfhi(b0.w);
        o[8] = bflo(a1.x) - lam * bflo(b1.x); o[9] = bfhi(a1.x) - lam * bfhi(b1.x); o[10] = bflo(a1.y) - lam * bflo(b1.y); o[11] = bfhi(a1.y) - lam * bfhi(b1.y);
        o[12] = bflo(a1.z) - lam * bflo(b1.z); o[13] = bfhi(a1.z) - lam * bfhi(b1.z); o[14] = bflo(a1.w) - lam * bflo(b1.w); o[15] = bfhi(a1.w) - lam * bfhi(b1.w);
        float ss = 0.f;
#pragma unroll
        for (int i = 0; i < 16; ++i) ss += o[i] * o[i];
        ss += __shfl_xor(ss, 1); ss += __shfl_xor(ss, 2); ss += __shfl_xor(ss, 4);
        const float rs = 1.f / sqrtf(ss * (1.f / 128.f) + RMS_EPS);
        v4u w0, w1;
        w0.x = pk2(o[0] * rs * gsub[0], o[1] * rs * gsub[1]); w0.y = pk2(o[2] * rs * gsub[2], o[3] * rs * gsub[3]); w0.z = pk2(o[4] * rs * gsub[4], o[5] * rs * gsub[5]); w0.w = pk2(o[6] * rs * gsub[6], o[7] * rs * gsub[7]);
        w1.x = pk2(o[8] * rs * gsub[8], o[9] * rs * gsub[9]); w1.y = pk2(o[10] * rs * gsub[10], o[11] * rs * gsub[11]); w1.z = pk2(o[12] * rs * gsub[12], o[13] * rs * gsub[13]); w1.w = pk2(o[14] * rs * gsub[14], o[15] * rs * gsub[15]);
        GAS v4u* po = (GAS v4u*)(CAT + (size_t)m * 2048 + h * 128 + e0); po[0] = w0; po[1] = w1;
        a0 = na0; a1 = na1; b0 = nb0; b1 = nb1;
    }
}

#define RLX_AGENT __ATOMIC_RELAXED, __HIP_MEMORY_SCOPE_AGENT
#define XB_TMO      128
#define XB_XCNT(j)  (256  + 64 * (j))
#define XB_XSUB(j)  (1280 + 64 * (j))
#define XB_XGEN(j)  (2304 + 64 * (j))
#define XB_TOP      3328
#define XB_TOPGEN   3392
#define XCD_BAR_WORDS 3456
#define XB_SPIN_CAP (1u << 18)

__device__ __forceinline__ unsigned xb_ld(unsigned* p)              { return __hip_atomic_load(p, __ATOMIC_RELAXED, __HIP_MEMORY_SCOPE_AGENT); }
__device__ __forceinline__ unsigned xb_add(unsigned* p, unsigned v) { return __hip_atomic_fetch_add(p, v, __ATOMIC_RELAXED, __HIP_MEMORY_SCOPE_AGENT); }
__device__ __forceinline__ unsigned xb_xcc_id() { return (unsigned)__builtin_amdgcn_s_getreg((3 << 11) | 20) & 0xFu; }
#define XB_SPIN(cond, bar) do { unsigned _sp = 0; while (cond) { __builtin_amdgcn_s_sleep(1); \
    if ((++_sp & 255u) == 0u) { if (xb_ld(&(bar)[XB_TMO])) break; if (_sp > XB_SPIN_CAP) { atomicAdd(&(bar)[XB_TMO], 1u); break; } } } } while (0)

struct XcdBarrier {
    unsigned* bar; unsigned x;
    volatile LAS unsigned* st;
};

__device__ __forceinline__ XcdBarrier xcd_barrier_post(unsigned* bar, volatile LAS unsigned* st) {
    XcdBarrier b; b.bar = bar; b.x = xb_xcc_id(); b.st = st;
    if (threadIdx.x == 0) (void)xb_add(&bar[XB_XCNT(b.x)], 1u);
    return b;
}
__device__ __forceinline__ void xcd_barrier_complete(unsigned* bar, unsigned x, unsigned& nloc, unsigned& nx) {
    const unsigned G = gridDim.x * gridDim.y * gridDim.z;
    unsigned sum, cnt, mine, sp = 0u;
    for (;;) {
        sum = 0u; cnt = 0u; mine = 0u;
#pragma unroll
        for (unsigned j = 0; j < 16; ++j) { const unsigned c = xb_ld(&bar[XB_XCNT(j)]); sum += c; cnt += (c > 0u) ? 1u : 0u; mine = (j == x) ? c : mine; }
        if (sum == G) break;
        __builtin_amdgcn_s_sleep(1);
        if ((++sp & 255u) == 0u) { if (xb_ld(&bar[XB_TMO])) break; if (sp > XB_SPIN_CAP) { atomicAdd(&bar[XB_TMO], 1u); break; } }
    }
    nloc = mine > 0u ? mine : 1u; nx = cnt > 0u ? cnt : 1u;
}

__device__ __forceinline__ void xcd_barrier(const XcdBarrier& b) {
    asm volatile("s_waitcnt vmcnt(0)" ::: "memory");
    __syncthreads();
    if (threadIdx.x == 0) {
        unsigned* bar = b.bar;
        __builtin_amdgcn_s_waitcnt(0);
        unsigned nloc = b.st[0], nx = b.st[1];
        if (nloc == 0u) { xcd_barrier_complete(bar, b.x, nloc, nx); b.st[0] = nloc; b.st[1] = nx; }
        const unsigned old = xb_add(&bar[XB_XSUB(b.x)], 1u);
        const unsigned gen = old / nloc;
        if (old + 1u == (gen + 1u) * nloc) {
            __builtin_amdgcn_fence(__ATOMIC_RELEASE, "agent");
            asm volatile("s_waitcnt vmcnt(0)" ::: "memory");
            const unsigned og = xb_add(&bar[XB_TOP], 1u);
            const unsigned tg = og / nx;
            if (og + 1u == (tg + 1u) * nx) xb_add(&bar[XB_TOPGEN], 1u);
            else XB_SPIN(xb_ld(&bar[XB_TOPGEN]) == tg, bar);
            __builtin_amdgcn_fence(__ATOMIC_ACQUIRE, "agent");
            xb_add(&bar[XB_XGEN(b.x)], 1u);
            asm volatile("s_waitcnt vmcnt(0)" ::: "memory");
        } else {
            XB_SPIN(xb_ld(&bar[XB_XGEN(b.x)]) == gen, bar);
            __builtin_amdgcn_fence(__ATOMIC_ACQUIRE, "agent");
            asm volatile("s_waitcnt vmcnt(0)" ::: "memory");
        }
    }
    __syncthreads();
}
struct Args { const float* in[29]; float* out; unsigned char* ws; int ph_lo, ph_hi; };
__global__ void __launch_bounds__(NWAVES * 64, 2) mk_fwd(Args args) {
    extern __shared__ __attribute__((aligned(16))) unsigned char lds[];
    Frame F;
    F.lds = (LAS unsigned char*)lds;
    F.tid = threadIdx.x; F.lane = F.tid & 63; F.wave = __builtin_amdgcn_readfirstlane(F.tid >> 6);
    F.G = gridDim.x; { const int bx = blockIdx.x; F.vcu = (F.G % 8 == 0) ? (bx % 8) * (F.G / 8) + bx / 8 : bx; }
    F.out = args.out; F.ws = args.ws;
    unsigned char* ws = args.ws;
    const float* mod = (const float*)(ws + WS_MOD);
    bf16* U = (bf16*)(ws + WS_U); bf16* ACT = (bf16*)(ws + WS_ACT); float* STATS = (float*)(ws + WS_STATS);
    constexpr bool YBF = MK_YBF16 != 0;
    const int lo = args.ph_lo, hi = args.ph_hi;
    int cbx = blockIdx.x;
#define IN(k) (lo <= (k) && (k) < hi)
#define PH_BEGIN() do { int t_ = threadIdx.x; asm volatile("" : "+v"(t_)); F.tid = t_; F.lane = t_ & 63; F.wave = __builtin_amdgcn_readfirstlane(t_ >> 6); } while (0)
#if MK_USE_CG
#define SEAM(k) do { if (IN(k) && IN((k) + 1)) { cg::this_grid().sync(); } } while (0)
#else
    volatile LAS unsigned* MISC = (volatile LAS unsigned*)(F.lds + MISC_OFF);
    if (threadIdx.x < 32) MISC[threadIdx.x] = 0u;
    __syncthreads();
    if (lo < 0) cg::this_grid().sync();
    XcdBarrier bar; bar.bar = (unsigned*)ws; bar.x = 0; bar.st = nullptr;
    if (hi - lo > 1) bar = xcd_barrier_post((unsigned*)ws, MISC + 8);
#if MK_XCCMAP
    if (hi - lo > 1 && threadIdx.x == 0) MISC[4] = xb_add((unsigned*)ws + 8192 + 64 * xb_xcc_id(), 1u);
    __syncthreads();
#endif
#define SEAM(k) do { if (IN(k) && IN((k) + 1)) { xcd_barrier(bar); } } while (0)
#endif

    if (IN(0)) for (int rep_ = 0; rep_ <= ((MK_DUP >> 0) & 1); ++rep_) { PH_BEGIN(); p0_prologue(F); } SEAM(0);
#if MK_XCCMAP && !MK_USE_CG
    if (IN(0) && IN(1)) {
        bool okmap = (F.G % 8) == 0;
#pragma unroll
        for (int j = 0; j < 16; ++j) { const unsigned cnt = xb_ld((unsigned*)ws + 8192 + 64 * j); okmap = okmap && (cnt == (j < 8 ? (unsigned)F.G / 8u : 0u)); }
        if (okmap) { const int xr = (int)MISC[4], xx = (int)xb_xcc_id(); cbx = xr * 8 + xx; F.vcu = xx * (F.G / 8) + xr; }
    }
#endif
    if (IN(1)) for (int rep_ = 0; rep_ <= ((MK_DUP >> 1) & 1); ++rep_) { PH_BEGIN(); modulate_phase(F, inp(0), mod + 0 * D, mod + 1 * D, U); } SEAM(1);
    if (IN(2)) for (int rep_ = 0; rep_ <= ((MK_DUP >> 2) & 1); ++rep_) { PH_BEGIN();
        pg8::Gemm g{U, (const pg8::bf16_t*)(ws + WS_W13A), M, 2 * FF, D}; pg8::StaticOrder S; S.init(M, 2 * FF, F.G, cbx);
        pg8::EpiSwiGLU E{ACT, FF};
        pg8::gemm_phase<pg8::EpiSwiGLU, pg8::StaticOrder, PG8_ALIGN, PG8_SP2>(F.lds + RING_OFF, g, S, E);
    } SEAM(2);
    if (IN(3)) for (int rep_ = 0; rep_ <= ((MK_DUP >> 3) & 1); ++rep_) { PH_BEGIN();
        pg8::Gemm g{ACT, (const pg8::bf16_t*)(ws + WS_W2A), M, D, FF}; pg8::StaticOrder S; S.init(M, D, F.G, cbx);
        pg8::EpiResid2<false, YBF> E{inp(0), F.out, STATS, nullptr, nullptr, mod + 2 * D, NCOND, DN_ALPHA, 0.5f};
        pg8::gemm_phase<pg8::EpiResid2<false, YBF>, pg8::StaticOrder, PG8_ALIGN, PG8_SP2>(F.lds + RING_OFF, g, S, E);
    } SEAM(3);
    if (IN(4)) for (int rep_ = 0; rep_ <= ((MK_DUP >> 4) & 1); ++rep_) { PH_BEGIN(); ln_phase2<false, YBF>(F, F.out, STATS, nullptr, inp(27) + 0 * D, inp(28) + 0 * D, mod + 3 * D, mod + 4 * D, U); } SEAM(4);
    if (IN(5)) for (int rep_ = 0; rep_ <= ((MK_DUP >> 5) & 1); ++rep_) { PH_BEGIN();
        pg8::Gemm g{U, (const pg8::bf16_t*)(ws + WS_WIN), M, 4096, D}; pg8::StaticOrder S; S.init(M, 4096, F.G, cbx);
        pg8::EpiInProj E{(pg8::bf16_t*)(ws + WS_Q), (pg8::bf16_t*)(ws + WS_K), (pg8::bf16_t*)(ws + WS_V), (float*)(ws + WS_S), attn_body::C2};
        pg8::gemm_phase<pg8::EpiInProj, pg8::StaticOrder, PG8_ALIGN, PG8_SP2>(F.lds + RING_OFF, g, S, E);
    } SEAM(5);
    if (IN(6)) for (int rep_ = 0; rep_ <= ((MK_DUP >> 6) & 1); ++rep_) { PH_BEGIN(); if (MK_S5BF) s5_scan_bf<false>(F); else s5_scan<false>(F); } SEAM(6);
    if (IN(7)) for (int rep_ = 0; rep_ <= ((MK_DUP >> 7) & 1); ++rep_) { PH_BEGIN();
        s5_carry(F);
        const attn_body::AttnTensors AT{(const attn_body::bf16*)(ws + WS_Q), (const attn_body::bf16*)(ws + WS_K), (const attn_body::bf16*)(ws + WS_V), (attn_body::bf16*)(ws + WS_OATT)};
        const attn_body::StaticOrder S((int)F.G, cbx);
        attn_body::attn_phase<attn_body::StaticOrder>((char*)lds + RING_OFF, AT, S);
    } SEAM(7);
    if (IN(8)) for (int rep_ = 0; rep_ <= ((MK_DUP >> 8) & 1); ++rep_) { PH_BEGIN(); if (MK_S5BF) s5_scan_bf<true>(F); else s5_scan<true>(F); attn_combine(F); } SEAM(8);
    if (IN(9)) for (int rep_ = 0; rep_ <= ((MK_DUP >> 9) & 1); ++rep_) { PH_BEGIN();
        pg8::Gemm g{(const pg8::bf16_t*)(ws + WS_G), (const pg8::bf16_t*)(ws + WS_GLU), M, 1024, 1024}; pg8::StaticOrder S; S.init(M, 1024, F.G, cbx);
        pg8::EpiGLU E{(const pg8::bf16_t*)(ws + WS_G), 1024, (pg8::bf16_t*)(ws + WS_CAT) + 1024, 2048, inp(22)};
        pg8::gemm_phase<pg8::EpiGLU, pg8::StaticOrder, PG8_ALIGN, PG8_SP2>(F.lds + RING_OFF, g, S, E);
    } SEAM(9);
    if (IN(10)) for (int rep_ = 0; rep_ <= ((MK_DUP >> 10) & 1); ++rep_) { PH_BEGIN();
        pg8::Gemm g{(const pg8::bf16_t*)(ws + WS_CAT), (const pg8::bf16_t*)(ws + WS_WOUT), M, D, D}; pg8::StaticOrder S; S.init(M, D, F.G, cbx);
        pg8::EpiResid2<true, YBF> E{F.out, F.out, STATS, inp(27) + 0 * D, inp(28) + 0 * D, mod + 5 * D, NCOND, DN_ALPHA, 1.0f};
        pg8::gemm_phase<pg8::EpiResid2<true, YBF>, pg8::StaticOrder, PG8_ALIGN, PG8_SP2>(F.lds + RING_OFF, g, S, E);
    } SEAM(10);
    if (IN(11)) for (int rep_ = 0; rep_ <= ((MK_DUP >> 11) & 1); ++rep_) { PH_BEGIN(); ln_phase2<false, YBF>(F, F.out, STATS, nullptr, inp(27) + 1 * D, inp(28) + 1 * D, mod + 6 * D, mod + 7 * D, U); } SEAM(11);
    if (IN(12)) for (int rep_ = 0; rep_ <= ((MK_DUP >> 12) & 1); ++rep_) { PH_BEGIN();
        pg8::Gemm g{U, (const pg8::bf16_t*)(ws + WS_W13B), M, 2 * FF, D}; pg8::StaticOrder S; S.init(M, 2 * FF, F.G, cbx);
        pg8::EpiSwiGLU E{ACT, FF};
        pg8::gemm_phase<pg8::EpiSwiGLU, pg8::StaticOrder, PG8_ALIGN, PG8_SP2>(F.lds + RING_OFF, g, S, E);
    } SEAM(12);
    if (IN(13)) for (int rep_ = 0; rep_ <= ((MK_DUP >> 13) & 1); ++rep_) { PH_BEGIN();
        pg8::Gemm g{ACT, (const pg8::bf16_t*)(ws + WS_W2B), M, D, FF}; pg8::StaticOrder S; S.init(M, D, F.G, cbx);
        pg8::EpiResid2<true, YBF> E{F.out, (void*)(ws + WS_Y3), STATS, inp(27) + 1 * D, inp(28) + 1 * D, mod + 8 * D, NCOND, DN_ALPHA, 0.5f};
        pg8::gemm_phase<pg8::EpiResid2<true, YBF>, pg8::StaticOrder, PG8_ALIGN, PG8_SP2>(F.lds + RING_OFF, g, S, E);
    } SEAM(13);
    if (IN(14)) for (int rep_ = 0; rep_ <= ((MK_DUP >> 14) & 1); ++rep_) { PH_BEGIN(); ln_phase2<true, YBF>(F, (const void*)(ws + WS_Y3), STATS, F.out, inp(27) + 2 * D, inp(28) + 2 * D, mod, mod, U); }
#undef IN
#undef SEAM
}

extern "C" void kernel_launch(void* const* d_in, const int* in_sizes, int n_in, void* d_out, int out_size, void* d_ws, size_t ws_size, hipStream_t stream) {
    static int inited = 0;
    if (!inited) {
        if (n_in != 29 || out_size != M * D || ws_size < WS_END) { fprintf(stderr, "kernel_launch: unexpected shapes (n_in %d, out %d, ws %zu)\n", n_in, out_size, ws_size); inited = -1; return; }
        if (hipFuncSetAttribute((const void*)mk_fwd, hipFuncAttributeMaxDynamicSharedMemorySize, LDS_BYTES) != hipSuccess) { fprintf(stderr, "kernel_launch: hipFuncSetAttribute failed\n"); inited = -1; return; }
        inited = 1;
    }
    if (inited < 0) return;
    Args a{};
    for (int i = 0; i < 29; ++i) a.in[i] = (const float*)d_in[i];
    a.out = (float*)d_out; a.ws = (unsigned char*)d_ws;
#if MK_N_LAUNCHES == 1
    a.ph_lo = 0; a.ph_hi = NPHASE;
#if !MK_USE_CG
    (void)hipMemsetAsync(d_ws, 0, CTL_ZERO_BYTES, stream);
#endif
    void* kargs[] = {&a};
    const hipError_t e = hipLaunchCooperativeKernel((const void*)mk_fwd, dim3(256), dim3(NWAVES * 64), kargs, LDS_BYTES, stream);
    if (e != hipSuccess) fprintf(stderr, "kernel_launch: cooperative launch failed: %s\n", hipGetErrorString(e));
#else
    for (int ph = 0; ph < NPHASE; ++ph) { a.ph_lo = ph; a.ph_hi = ph + 1; hipLaunchKernelGGL(mk_fwd, dim3(256), dim3(NWAVES * 64), LDS_BYTES, stream, a); }
#endif
}
```
